# Optimizing an MI355X kernel written in HIP

```python
import jax, jax.numpy as jnp
from jax import lax
import numpy as np

D_MODEL = 1024
BATCH = 8
SEQ = 2048
DEPTH = 1

CHUNK = 64
EPS = 1e-6
POOL_WIDTH = 512
POOL_WINDOWS = (2, 4, 8, 16)
POOL_GROUPS = len(POOL_WINDOWS)
POOL_GROUP_DIM = POOL_WIDTH // POOL_GROUPS
POOL_MAX_WIN = max(POOL_WINDOWS)
GLA_HEADS = 4
GLA_DK = D_MODEL // 2
GLA_DV = D_MODEL
GLA_HK = GLA_DK // GLA_HEADS
GLA_HV = GLA_DV // GLA_HEADS
GLA_GATE_RANK = 16
GLA_GATE_NORM = 16.0
N_BRANCH = 2
D_FF = 2816
CONV_W = 3

IN_WIDTHS = (POOL_WIDTH, GLA_DK, GLA_DK, GLA_DV, GLA_DV, GLA_GATE_RANK, N_BRANCH * D_MODEL)
IN_TOTAL = sum(IN_WIDTHS)
IN_OFFSETS = tuple(int(o) for o in np.cumsum(IN_WIDTHS)[:-1])

kernel_name = "hybrid_pool_gla_convffn"


def rmsnorm(x, g):
    xf = x.astype(jnp.float32)
    y = xf * lax.rsqrt(jnp.mean(xf * xf, axis=-1, keepdims=True) + EPS)
    return (y * g.astype(jnp.float32)).astype(x.dtype)


def pool_mixer(u, w_grp, scale):
    B, S, _ = u.shape
    uf = u.astype(jnp.float32)
    cs = jnp.pad(jnp.cumsum(uf, axis=1), ((0, 0), (POOL_MAX_WIN, 0), (0, 0)))
    pos = jnp.arange(S, dtype=jnp.float32)
    outs = []
    for g, w in enumerate(POOL_WINDOWS):
        sl = slice(g * POOL_GROUP_DIM, (g + 1) * POOL_GROUP_DIM)
        win_sum = cs[:, POOL_MAX_WIN:, sl] - cs[:, POOL_MAX_WIN - w:POOL_MAX_WIN - w + S, sl]
        count = jnp.minimum(pos + 1.0, float(w))[None, :, None]
        outs.append(win_sum / count - uf[..., sl])
    p = jnp.stack(outs, axis=2).astype(u.dtype)
    p = jnp.einsum('bsgc,gcd->bsgd', p, w_grp).reshape(B, S, POOL_WIDTH)
    return p * scale


def gla_chunk_causal(q, k, v, log_a):
    B, S, H, K = q.shape
    V = v.shape[-1]
    N = S // CHUNK
    f32 = jnp.float32
    qf = (q.astype(f32) * (K ** -0.5)).reshape(B, N, CHUNK, H, K)
    kf = k.astype(f32).reshape(B, N, CHUNK, H, K)
    vf = v.astype(f32).reshape(B, N, CHUNK, H, V)
    bc = jnp.cumsum(log_a.astype(f32).reshape(B, N, CHUNK, H, K), axis=2)
    e_pos, e_neg = jnp.exp(bc), jnp.exp(-bc)
    q_fw, k_fw = qf * e_pos, kf * e_neg
    q_bw, k_bw = qf * e_neg, kf * e_pos
    s_fw = jnp.einsum('bnthk,bnshk->bnhts', q_fw, k_fw)
    s_bw = jnp.einsum('bnthk,bnshk->bnhts', q_bw, k_bw)
    lower = jnp.tril(jnp.ones((CHUNK, CHUNK), dtype=bool))
    scores = jnp.where(lower, s_fw, s_bw)
    intra = jnp.einsum('bnhts,bnshv->bnthv', scores, vf)
    b_last = bc[:, :, -1]
    k_dec = kf * jnp.exp(b_last[:, :, None] - bc)
    kv = jnp.einsum('bnshk,bnshv->bnhkv', k_dec, vf)

    def step(state, inp):
        decay, kv_c = inp
        return decay[..., None] * state + kv_c, state

    xs = (jnp.moveaxis(jnp.exp(b_last), 1, 0), jnp.moveaxis(kv, 1, 0))
    _, s_prev = lax.scan(step, jnp.zeros((B, H, K, V), f32), xs)
    inter = jnp.einsum('bnthk,nbhkv->bnthv', q_fw, s_prev)
    return (intra + inter).reshape(B, S, H, V)


def conv_ffn(h, w_up, w_conv, b_conv, w_down):
    S = h.shape[1]
    u = h @ w_up
    up = jnp.pad(u, ((0, 0), (CONV_W - 1, 0), (0, 0)))
    c = b_conv + sum(up[:, j:j + S] * w_conv[j] for j in range(CONV_W))
    gate, val = jnp.split(c, 2, axis=-1)
    return (jax.nn.silu(gate) * val) @ w_down


def setup_inputs(seed: int = 0) -> dict:
    key = jax.random.key(seed)
    ks = jax.random.split(key, 20)
    f32 = jnp.float32
    L = DEPTH

    def nrm(k, shape, scale):
        return jax.random.normal(k, shape, f32) * scale

    return {
        "x": nrm(ks[0], (BATCH, SEQ, D_MODEL), 1.0),
        "g_mix": 1.0 + nrm(ks[1], (L, D_MODEL), 0.02),
        "w_in": nrm(ks[2], (L, D_MODEL, IN_TOTAL), D_MODEL ** -0.5),
        "b_gate": nrm(ks[3], (L, N_BRANCH * D_MODEL), 0.01),
        "w_gk_up": nrm(ks[4], (L, GLA_GATE_RANK, GLA_DK), GLA_GATE_RANK ** -0.5),
        "b_gk": nrm(ks[5], (L, GLA_DK), 0.1),
        "w_pool_grp": nrm(ks[6], (L, POOL_GROUPS, POOL_GROUP_DIM, POOL_GROUP_DIM), POOL_GROUP_DIM ** -0.5),
        "pool_scale": 1.0 + nrm(ks[7], (L, POOL_WIDTH), 0.02),
        "g_gla_head": 1.0 + nrm(ks[8], (L, GLA_HV), 0.02),
        "w_pool_proj": nrm(ks[9], (L, POOL_WIDTH, D_MODEL), POOL_WIDTH ** -0.5),
        "w_gla_proj": nrm(ks[10], (L, GLA_DV, D_MODEL), GLA_DV ** -0.5),
        "w_out": nrm(ks[11], (L, D_MODEL, D_MODEL), D_MODEL ** -0.5),
        "g_ffn": 1.0 + nrm(ks[12], (L, D_MODEL), 0.02),
        "w_up": nrm(ks[13], (L, D_MODEL, 2 * D_FF), D_MODEL ** -0.5),
        "w_conv": nrm(ks[14], (L, CONV_W, 2 * D_FF), CONV_W ** -0.5),
        "b_conv": nrm(ks[15], (L, 2 * D_FF), 0.01),
        "w_down": nrm(ks[16], (L, D_FF, D_MODEL), D_FF ** -0.5),
        "g_final": 1.0 + nrm(ks[17], (D_MODEL,), 0.02),
    }


def reference(x, g_mix, w_in, b_gate, w_gk_up, b_gk, w_pool_grp, pool_scale, g_gla_head,
              w_pool_proj, w_gla_proj, w_out, g_ffn, w_up, w_conv, b_conv, w_down, g_final):
    B, S, _ = x.shape
    for l in range(DEPTH):
        h = rmsnorm(x, g_mix[l])
        z = h @ w_in[l]
        z_pool, z_q, z_k, z_v, z_og, z_gk, z_gate = jnp.split(z, IN_OFFSETS, axis=-1)
        y_pool = pool_mixer(z_pool, w_pool_grp[l], pool_scale[l]) @ w_pool_proj[l]
        log_a = jax.nn.log_sigmoid((z_gk @ w_gk_up[l] + b_gk[l]).astype(jnp.float32)) / GLA_GATE_NORM
        o = gla_chunk_causal(
            z_q.reshape(B, S, GLA_HEADS, GLA_HK),
            z_k.reshape(B, S, GLA_HEADS, GLA_HK),
            z_v.reshape(B, S, GLA_HEADS, GLA_HV),
            log_a.reshape(B, S, GLA_HEADS, GLA_HK))
        o = rmsnorm(o, g_gla_head[l]).reshape(B, S, GLA_DV).astype(x.dtype) * jax.nn.silu(z_og)
        y_gla = o @ w_gla_proj[l]
        gates = jax.nn.sigmoid(z_gate + b_gate[l]).reshape(B, S, N_BRANCH, D_MODEL)
        mixed = gates[:, :, 0] * y_pool + gates[:, :, 1] * y_gla
        x = x + mixed @ w_out[l]
        h2 = rmsnorm(x, g_ffn[l])
        x = x + conv_ffn(h2, w_up[l], w_conv[l], b_conv[l], w_down[l])
    return rmsnorm(x, g_final)
```

```cpp
#include <hip/hip_runtime.h>
#include <hip/hip_cooperative_groups.h>
#include <cstdio>
namespace cg = cooperative_groups;
namespace pg8 {
#define PG8_LAS __attribute__((address_space(3)))
typedef unsigned short bf16_t;
typedef short bf16x8 __attribute__((ext_vector_type(8)));
typedef float f32x4 __attribute__((ext_vector_type(4)));
typedef unsigned u32x4 __attribute__((ext_vector_type(4)));
constexpr int BM = 256, BK = 64, HALF = 128, HTB = HALF * BK * 2  , STAGE_BYTES = 8 * HTB, NXCD = 8, WGM = 8;

__host__ __device__ __forceinline__ int lds_byte(int r, int c) { const int st = (r >> 4) * 2 + (c >> 5), rr = r & 15, cc = c & 31, ob = rr * 64 + cc * 2; return st * 1024 + (ob ^ (((ob >> 9) & 1) << 5)); }
__host__ __device__ __forceinline__ void stage_rc(int b, int& R, int& C) { const int st = b / 1024, sb = b % 1024, swz = sb ^ (((sb >> 9) & 1) << 5); R = (st >> 1) * 16 + swz / 64; C = (st & 1) * 32 + (swz % 64) / 2; }
__host__ __device__ __forceinline__ int perm32(int rho) { const int n = rho >> 4, i = rho & 15; return 8 * (i >> 2) + 4 * n + (i & 3); }

struct Unit { int pm, pn; };
struct Gemm { const bf16_t* A; const bf16_t* Bt; int M, N, K; };

struct StaticOrder {
    int nM, nN, nwg, G, c;
    __host__ __device__ void init(int M, int N, int G_, int c_) { nM = M / BM; nN = N / BM; nwg = nM * nN; G = G_; c = c_; }
    __host__ __device__ bool next(int i, Unit& u) const {
        const long L = (long)i * G + c; if (L >= nwg) return false;
        int wgid = (int)L; { const int q = nwg / NXCD, r = nwg % NXCD, xcd = wgid % NXCD, off = wgid / NXCD; wgid = (xcd < r ? xcd * (q + 1) : r * (q + 1) + (xcd - r) * q) + off; }
        const int nig = WGM * nN, gid = wgid / nig, fm = gid * WGM, gsz = (nM - fm) < WGM ? (nM - fm) : WGM;
        u.pm = fm + ((wgid % nig) % gsz); u.pn = (wgid % nig) / gsz; return true;
    }
    __device__ __forceinline__ void a_ready(const Unit&) const {}
    __device__ __forceinline__ void done(const Unit&) const {}
};
typedef float f32x2 __attribute__((ext_vector_type(2)));
typedef __bf16 bf16x2_t __attribute__((ext_vector_type(2)));
__device__ __forceinline__ unsigned cvt_pk_bf16(float lo, float hi) { const f32x2 v = {lo, hi}; const bf16x2_t r = __builtin_convertvector(v, bf16x2_t); return __builtin_bit_cast(unsigned, r); }
template <class Epi, class Sched, bool STAMP = false>
__device__ __forceinline__ void gemm_phase(PG8_LAS unsigned char* lds, const Gemm g, const Sched& S, const Epi& E, unsigned long long* stamps) {
    const int tid = threadIdx.x, wid = __builtin_amdgcn_readfirstlane(tid >> 6), lane = tid & 63, wr = wid >> 2, wc = wid & 3, fr = lane & 15, fq = lane >> 4;
    const int K = g.K, nt = K / BK;
    int ts_lo = 0, ts_hi = 0, nts = 0; const unsigned long long rt_entry = STAMP ? (unsigned long long)wall_clock64() : 0ull;
#define PG8_STAMP() do { if (STAMP && wid == 0 && nts < 64) { const unsigned long long _c = (unsigned long long)clock64(); \
        ts_lo = (lane == nts) ? (int)(unsigned)_c : ts_lo; ts_hi = (lane == nts) ? (int)(unsigned)(_c >> 32) : ts_hi; ++nts; } } while (0)
    PG8_STAMP();
    unsigned voffA[2], voffB[2];
#pragma unroll
    for (int i = 0; i < 2; ++i) { int R, C; stage_rc(tid * 16 + i * 8192, R, C); const int Rb = Epi::PERM ? ((R & ~31) + perm32(R & 31)) : R;
        voffA[i] = (unsigned)(R * K + C) * 2u; voffB[i] = (unsigned)(Rb * K + C) * 2u; }
    const size_t kstep = (size_t)(BK * 2);
    const size_t hstep = (size_t)HALF * K * 2;
    const size_t tstep = 2 * hstep;
    const unsigned ldsw = (unsigned)wid * 1024u;
    const int aoff = lds_byte(wr * 64 + fr, fq * 8), boff = lds_byte(wc * 32 + fr, fq * 8);
#define PG8_SA(b, h) (((b) * 2 + (h)) * HTB)
#define PG8_SB(b, h) ((4 + (b) * 2 + (h)) * HTB)
#define PG8_STAGE(bufoff, gbase, voff) do { _Pragma("unroll") for (int _i = 0; _i < 2; ++_i) \
        __builtin_amdgcn_global_load_lds((const unsigned*)((const char*)(gbase) + (voff)[_i]), (PG8_LAS unsigned*)(lds + (bufoff) + ldsw + _i * 8192), 16, 0, 0); } while (0)
#define PG8_LDA(dst, b, h) do { _Pragma("unroll") for (int m = 0; m < 4; ++m) _Pragma("unroll") for (int k = 0; k < 2; ++k) dst[m][k] = *(const PG8_LAS bf16x8*)(lds + PG8_SA(b, h) + aoff + m * 2048 + k * 1024); } while (0)
#define PG8_LDB(dst, b, h) do { _Pragma("unroll") for (int n = 0; n < 2; ++n) _Pragma("unroll") for (int k = 0; k < 2; ++k) dst[n][k] = *(const PG8_LAS bf16x8*)(lds + PG8_SB(b, h) + boff + n * 2048 + k * 1024); } while (0)
#define PG8_MMA(ai, bj, At, Bt) do { __builtin_amdgcn_s_setprio(1); _Pragma("unroll") for (int m = 0; m < 4; ++m) _Pragma("unroll") for (int n = 0; n < 2; ++n) _Pragma("unroll") for (int k = 0; k < 2; ++k) \
        acc[ai][bj][m][n] = __builtin_amdgcn_mfma_f32_16x16x32_bf16(Bt[n][k], At[m][k], acc[ai][bj][m][n], 0, 0, 0); __builtin_amdgcn_s_setprio(0); } while (0)
#define PG8_WAIT_V(n) asm volatile("s_waitcnt vmcnt(" #n ")" ::: "memory")
#define PG8_WAIT_L(n) asm volatile("s_waitcnt lgkmcnt(" #n ")" ::: "memory")
#define PG8_BAR __builtin_amdgcn_s_barrier()
#define PG8_SCHED __builtin_amdgcn_sched_barrier(0)
    Unit cur, nxt; int ui = 0;
    if (!S.next(0, cur)) return;
    f32x4 acc[2][2][4][2];
#pragma unroll
    for (int a = 0; a < 2; ++a)
#pragma unroll
        for (int b = 0; b < 2; ++b)
#pragma unroll
            for (int m = 0; m < 4; ++m)
#pragma unroll
                for (int n = 0; n < 2; ++n) acc[a][b][m][n] = (f32x4){0.f, 0.f, 0.f, 0.f};
    bf16x8 At[4][2], B0[2][2], B1[2][2];
    const char* cA = (const char*)g.A + (size_t)cur.pm * tstep; const char* cB = (const char*)g.Bt + (size_t)cur.pn * tstep;
    S.a_ready(cur);
    PG8_STAGE(PG8_SB(0, 0), cB, voffB); PG8_STAGE(PG8_SA(0, 0), cA, voffA); PG8_STAGE(PG8_SB(0, 1), cB + hstep, voffB); PG8_STAGE(PG8_SA(0, 1), cA + hstep, voffA);
    if (wr == 1) PG8_BAR;
    PG8_WAIT_V(4); PG8_BAR;
    PG8_STAGE(PG8_SB(1, 0), cB + kstep, voffB); PG8_STAGE(PG8_SA(1, 0), cA + kstep, voffA); PG8_STAGE(PG8_SB(1, 1), cB + hstep + kstep, voffB);
    PG8_WAIT_V(6); PG8_BAR;
    PG8_STAMP();
    for (;;) {
        const bool has_next = S.next(ui + 1, nxt);
        const char* nA = has_next ? (const char*)g.A + (size_t)nxt.pm * tstep : cA; const char* nB = has_next ? (const char*)g.Bt + (size_t)nxt.pn * tstep : cB;
        for (int t = 0; t < nt; t += 2) {
            const bool last = (t == nt - 2);
            const char* a1 = cA + (size_t)(t + 1) * kstep;
            const char* a2 = last ? nA : cA + (size_t)(t + 2) * kstep; const char* b2 = last ? nB : cB + (size_t)(t + 2) * kstep;
            const char* a3 = a2 + kstep; const char* b3 = b2 + kstep;
            if (last && has_next) S.a_ready(nxt);
            PG8_LDB(B0, 0, 0); PG8_SCHED; PG8_LDA(At, 0, 0); PG8_STAGE(PG8_SA(1, 1), a1 + hstep, voffA);
            PG8_WAIT_L(8); PG8_BAR; PG8_WAIT_L(0); PG8_MMA(0, 0, At, B0); PG8_BAR; PG8_SCHED;
            PG8_LDB(B1, 0, 1); PG8_STAGE(PG8_SB(0, 0), b2, voffB);
            PG8_BAR; PG8_WAIT_L(0); PG8_MMA(0, 1, At, B1); PG8_BAR;
            PG8_LDA(At, 0, 1); PG8_STAGE(PG8_SA(0, 0), a2, voffA);
            PG8_BAR; PG8_WAIT_L(0); PG8_MMA(1, 0, At, B0); PG8_BAR; PG8_SCHED;
            PG8_STAGE(PG8_SB(0, 1), b2 + hstep, voffB);
            PG8_WAIT_V(6); PG8_BAR; PG8_MMA(1, 1, At, B1); PG8_BAR;
            PG8_LDB(B0, 1, 0); PG8_SCHED; PG8_LDA(At, 1, 0); PG8_STAGE(PG8_SA(0, 1), a2 + hstep, voffA);
            PG8_WAIT_L(8); PG8_BAR; PG8_WAIT_L(0); PG8_MMA(0, 0, At, B0); PG8_BAR; PG8_SCHED;
            PG8_LDB(B1, 1, 1); PG8_STAGE(PG8_SB(1, 0), b3, voffB);
            PG8_BAR; PG8_WAIT_L(0); PG8_MMA(0, 1, At, B1); PG8_BAR;
            PG8_LDA(At, 1, 1); PG8_STAGE(PG8_SA(1, 0), a3, voffA);
            PG8_BAR; PG8_WAIT_L(0); PG8_MMA(1, 0, At, B0); PG8_BAR; PG8_SCHED;
            PG8_STAGE(PG8_SB(1, 1), b3 + hstep, voffB);
            PG8_WAIT_V(6); PG8_BAR; PG8_MMA(1, 1, At, B1); PG8_BAR;
        }
        PG8_STAMP();
        if constexpr (!Epi::AFTER_DRAIN) { E(acc, cur, wr, wc, fr, fq); S.done(cur); }
        PG8_STAMP();
        if (!has_next) break;
#pragma unroll
        for (int a = 0; a < 2; ++a)
#pragma unroll
            for (int b = 0; b < 2; ++b)
#pragma unroll
                for (int m = 0; m < 4; ++m)
#pragma unroll
                    for (int n = 0; n < 2; ++n) acc[a][b][m][n] = (f32x4){0.f, 0.f, 0.f, 0.f};
        cur = nxt; cA = nA; cB = nB; ++ui;
    }
    PG8_WAIT_V(0);
    if (wr == 0) PG8_BAR;
    PG8_BAR;
    if constexpr (Epi::AFTER_DRAIN) { E.fused(acc, cur, wr, wc, fr, fq, lds, wid, lane); S.done(cur); }
    PG8_STAMP();
    if (STAMP && wid == 0) { stamps[lane] = lane < nts ? (((unsigned long long)(unsigned)ts_hi << 32) | (unsigned)ts_lo) : 0ull;
        if (lane == 62) stamps[62] = rt_entry; if (lane == 63) stamps[63] = (unsigned long long)wall_clock64(); }
#undef PG8_STAMP
#undef PG8_SA
#undef PG8_SB
#undef PG8_STAGE
#undef PG8_LDA
#undef PG8_LDB
#undef PG8_MMA
#undef PG8_WAIT_V
#undef PG8_WAIT_L
#undef PG8_BAR
#undef PG8_SCHED
}
}

#define MK_PER_PHASE 0
#define MK_NPH 13
#define MK_DUMPSEL 1

#define LAS __attribute__((address_space(3)))
using pg8::bf16_t; using pg8::bf16x8; using pg8::f32x4; using pg8::u32x4;
typedef unsigned u32x2 __attribute__((ext_vector_type(2)));
constexpr int T = 16384, D = 1024, NIN = 5888, DFF = 2816;
constexpr float EPS = 1e-6f;
constexpr size_t MiB = 1u << 20;
constexpr size_t WS_WIN = 0, WS_WEFF = 12 * MiB, WS_WGP = 13 * MiB, WS_WOUT = 15 * MiB, WS_WUP = 17 * MiB, WS_WDOWN = 28 * MiB;
constexpr size_t WS_XB = 34 * MiB;
constexpr size_t WS_ZPOOL = 66 * MiB, WS_Q = 82 * MiB, WS_K = 98 * MiB, WS_V = 114 * MiB, WS_OG = 146 * MiB, WS_GATES = 178 * MiB;
constexpr size_t WS_ZGK = 242 * MiB, WS_RSTD1 = 243 * MiB, WS_SSQ2 = WS_RSTD1 + 65536, WS_SSQ3 = WS_SSQ2 + 65536, WS_DVEC = WS_SSQ3 + 65536;
constexpr size_t WS_YPG = WS_Q, WS_MIXED = WS_OG;
constexpr size_t WS_UH = 66 * MiB, WS_A = 154 * MiB;
constexpr int LDS_BYTES = 131072;
constexpr int L_ZGK = 0, L_TOT = 4096, L_RED = 6144, L_VT = 8192, L_KD = 45056, L_QF = 45056, L_QB = 62464, L_KF = 79872, L_KB = 97280, L_P = 114688;

struct Params {
    const float *x, *g_mix, *w_in, *b_gate, *w_gk_up, *b_gk, *w_pool_grp, *pool_scale, *g_gla_head, *w_pool_proj, *w_gla_proj, *w_out, *g_ffn, *w_up, *w_conv, *b_conv, *w_down, *g_final;
    float* out; unsigned char* ws; int ph_lo, ph_hi;
};

__device__ __forceinline__ unsigned pk2(float lo, float hi) { return pg8::cvt_pk_bf16(lo, hi); }
__device__ __forceinline__ float bf2f(unsigned b) { return __uint_as_float(b << 16); }
__device__ __forceinline__ float bflo(unsigned w) { return __uint_as_float(w << 16); }
__device__ __forceinline__ float bfhi(unsigned w) { return __uint_as_float(w & 0xffff0000u); }
__device__ __forceinline__ bf16_t f2bf(float f) { unsigned u = __float_as_uint(f); u += 0x7FFFu + ((u >> 16) & 1u); return (bf16_t)(u >> 16); }
__device__ __forceinline__ float wave_sum(float v) {
#pragma unroll
    for (int o = 1; o < 64; o <<= 1) v += __shfl_xor(v, o);
    return v;
}
__device__ __forceinline__ float sigmoidf_(float x) { return 1.0f / (1.0f + __expf(-x)); }
#define GRID_SYNC() do { asm volatile("s_waitcnt vmcnt(0) lgkmcnt(0)" ::: "memory"); grid.sync(); } while (0)
#define LDS_WAIT() asm volatile("s_waitcnt lgkmcnt(0)" ::: "memory")
#define MFMA16(a, b, c) __builtin_amdgcn_mfma_f32_16x16x32_bf16((a), (b), (c), 0, 0, 0)

__device__ __forceinline__ void tr_item(const float* W, int ldw, int K, bf16_t* WT, int drow0, int scol0, int nvalid, const float* scale, int smask, int k0, LAS float* scr, int lane) {
    const int n = lane & 31;
#pragma unroll 8
    for (int i = 0; i < 32; ++i) {
        const int kk = 2 * i + (lane >> 5); float v = 0.f;
        if (n < nvalid) { v = W[(size_t)(k0 + kk) * ldw + scol0 + n]; if (scale) v *= scale[(k0 + kk) & smask]; }
        scr[kk * 33 + n] = v;
    }
    LDS_WAIT(); asm volatile("" ::: "memory");
    const int c = lane & 7;
#pragma unroll
    for (int j = 0; j < 4; ++j) {
        const int nn = (lane >> 3) + 8 * j; const LAS float* s = scr + (8 * c) * 33 + nn;
        u32x4 o; o.x = pk2(s[0 * 33], s[1 * 33]); o.y = pk2(s[2 * 33], s[3 * 33]); o.z = pk2(s[4 * 33], s[5 * 33]); o.w = pk2(s[6 * 33], s[7 * 33]);
        *(u32x4*)(WT + (size_t)(drow0 + nn) * K + k0 + 8 * c) = o;
    }
    LDS_WAIT(); asm volatile("" ::: "memory");
}

__device__ __forceinline__ void p0_prologue(const Params& P, LAS unsigned char* lds, int tid, int lane, int wave) {
    unsigned char* ws = P.ws;
    const int G = gridDim.x, bid = blockIdx.x;
    { const int gt = bid * 512 + tid; if (gt < T) { ((float*)(ws + WS_SSQ2))[gt] = 0.f; ((float*)(ws + WS_SSQ3))[gt] = 0.f; } }
    for (int it = bid; it < 64; it += G) {
        const int g = it >> 4, n0 = (it & 15) * 64;
        LAS float* LW = (LAS float*)lds;
        LAS float* LP = (LAS float*)(lds + 66560);
        __syncthreads();
        for (int i = 0; i < 32; ++i) { const int idx = tid + 512 * i; LW[(idx >> 7) * 129 + (idx & 127)] = P.w_pool_grp[(size_t)g * 16384 + idx]; }
        for (int i = 0; i < 16; ++i) { const int idx = tid + 512 * i; const int d = idx >> 6, nn = idx & 63; LP[idx] = P.w_pool_proj[(size_t)(g * 128 + d) * 1024 + n0 + nn] * P.pool_scale[g * 128 + d]; }
        __syncthreads();
        const int c = tid & 127, nq = tid >> 7;
        float acc[16];
#pragma unroll
        for (int j = 0; j < 16; ++j) acc[j] = 0.f;
        for (int d = 0; d < 128; ++d) {
            const float w = LW[c * 129 + d]; const LAS f32x4* pr = (const LAS f32x4*)(LP + d * 64 + nq * 16);
#pragma unroll
            for (int j4 = 0; j4 < 4; ++j4) { const f32x4 pv = pr[j4]; acc[4 * j4 + 0] += w * pv.x; acc[4 * j4 + 1] += w * pv.y; acc[4 * j4 + 2] += w * pv.z; acc[4 * j4 + 3] += w * pv.w; }
        }
        bf16_t* WeffT = (bf16_t*)(ws + WS_WEFF);
#pragma unroll
        for (int j = 0; j < 16; ++j) WeffT[(size_t)(n0 + nq * 16 + j) * 512 + g * 128 + c] = f2bf(acc[j]);
    }
    __syncthreads();
    LAS float* scr = (LAS float*)(lds + wave * 16384);
    const int gw = bid * 8 + wave, NGW = G * 8;
    for (int it = gw; it < 8192; it += NGW) {
        int r = it;
        if (r < 2944) { const int kb = r / 184, nb = r % 184, drow0 = nb * 32; int scol0, nvalid = 32;
            if (drow0 < 3584) scol0 = drow0; else if (drow0 < 5632) scol0 = drow0 + 16; else if (drow0 == 5632) { scol0 = 3584; nvalid = 16; } else { scol0 = 0; nvalid = 0; }
            tr_item(P.w_in, 5648, 1024, (bf16_t*)(ws + WS_WIN), drow0, scol0, nvalid, P.g_mix, 1023, kb * 64, scr, lane); continue; }
        r -= 2944;
        if (r < 2816) { const int kb = r / 176, nb = r % 176, drow0 = nb * 32; const int pn = drow0 >> 8, bj = (drow0 >> 7) & 1, c0 = drow0 & 127;
            tr_item(P.w_up, 5632, 1024, (bf16_t*)(ws + WS_WUP), drow0, bj * 2816 + 128 * pn + c0, 32, P.g_ffn, 1023, kb * 64, scr, lane); continue; }
        r -= 2816;
        if (r < 1408) { const int kb = r / 32, nb = r % 32; tr_item(P.w_down, 1024, 2816, (bf16_t*)(ws + WS_WDOWN), nb * 32, nb * 32, 32, nullptr, 0, kb * 64, scr, lane); continue; }
        r -= 1408;
        if (r < 512) { const int kb = r / 32, nb = r % 32; tr_item(P.w_gla_proj, 1024, 1024, (bf16_t*)(ws + WS_WGP), nb * 32, nb * 32, 32, P.g_gla_head, 255, kb * 64, scr, lane); continue; }
        r -= 512;
        { const int kb = r / 32, nb = r % 32; tr_item(P.w_out, 1024, 1024, (bf16_t*)(ws + WS_WOUT), nb * 32, nb * 32, 32, nullptr, 0, kb * 64, scr, lane); }
    }
    bf16_t* xb = (bf16_t*)(ws + WS_XB); float* rstd1 = (float*)(ws + WS_RSTD1);
    for (int m = gw; m < T; m += NGW) {
        const f32x4* xr = (const f32x4*)(P.x + (size_t)m * D) + lane;
        f32x4 v[4]; float s = 0.f;
#pragma unroll
        for (int j = 0; j < 4; ++j) { v[j] = xr[64 * j]; s += (v[j].x * v[j].x + v[j].y * v[j].y) + (v[j].z * v[j].z + v[j].w * v[j].w); }
        s = wave_sum(s);
        u32x2* o8 = (u32x2*)(xb + (size_t)m * D) + lane;
#pragma unroll
        for (int j = 0; j < 4; ++j) { u32x2 o; o.x = pk2(v[j].x, v[j].y); o.y = pk2(v[j].z, v[j].w); o8[64 * j] = o; }
        if (lane == 0) rstd1[m] = rsqrtf(s * (1.0f / D) + EPS);
    }
}

struct EpiIn {
    static constexpr bool PERM = true, AFTER_DRAIN = false;
    unsigned char* ws; const float* bgate;
    __device__ __forceinline__ void operator()(const f32x4 (&acc)[2][2][4][2], const pg8::Unit& u, int wr, int wc, int fr, int fq) const {
        const int pn = u.pn; const float* rstd = (const float*)(ws + WS_RSTD1);
        const int row0 = u.pm * 256 + wr * 64 + fr;
        if (pn == 22) {
            float* zgk = (float*)(ws + WS_ZGK);
#pragma unroll
            for (int ai = 0; ai < 2; ++ai)
#pragma unroll
                for (int m = 0; m < 4; ++m) { const int row = row0 + ai * 128 + m * 16; const float rs = rstd[row];
                    if (wc == 0 && fq < 2) { *(f32x4*)(zgk + (size_t)row * 16 + 8 * fq) = acc[ai][0][m][0] * rs; *(f32x4*)(zgk + (size_t)row * 16 + 8 * fq + 4) = acc[ai][0][m][1] * rs; } }
            return;
        }
        bf16_t* base; int ldc, colt, mode = 0; float mul = 1.f;
        if (pn < 2) { base = (bf16_t*)(ws + WS_ZPOOL); ldc = 512; colt = pn * 256; }
        else if (pn < 4) { base = (bf16_t*)(ws + WS_Q); ldc = 512; colt = (pn - 2) * 256; mul = 0.08838834764831845f; }
        else if (pn < 6) { base = (bf16_t*)(ws + WS_K); ldc = 512; colt = (pn - 4) * 256; }
        else if (pn < 10) { base = (bf16_t*)(ws + WS_V); ldc = 1024; colt = (pn - 6) * 256; }
        else if (pn < 14) { base = (bf16_t*)(ws + WS_OG); ldc = 1024; colt = (pn - 10) * 256; mode = 1; }
        else { base = (bf16_t*)(ws + WS_GATES); ldc = 2048; colt = (pn - 14) * 256; mode = 2; }
        const int col0 = colt + wc * 32 + 8 * fq;
        f32x4 bv[2][2];
#pragma unroll
        for (int bj = 0; bj < 2; ++bj)
#pragma unroll
            for (int n = 0; n < 2; ++n) bv[bj][n] = (mode == 2) ? *(const f32x4*)(bgate + col0 + bj * 128 + 4 * n) : (f32x4){0.f, 0.f, 0.f, 0.f};
#pragma unroll
        for (int ai = 0; ai < 2; ++ai)
#pragma unroll
            for (int m = 0; m < 4; ++m) { const int row = row0 + ai * 128 + m * 16; const float rs = rstd[row] * mul; bf16_t* rowp = base + (size_t)row * ldc + col0;
#pragma unroll
                for (int bj = 0; bj < 2; ++bj) { f32x4 v0 = acc[ai][bj][m][0] * rs + bv[bj][0], v1 = acc[ai][bj][m][1] * rs + bv[bj][1];
                    if (mode == 1) {
#pragma unroll
                        for (int j = 0; j < 4; ++j) { v0[j] = v0[j] * sigmoidf_(v0[j]); v1[j] = v1[j] * sigmoidf_(v1[j]); } }
                    else if (mode == 2) {
#pragma unroll
                        for (int j = 0; j < 4; ++j) { v0[j] = sigmoidf_(v0[j]); v1[j] = sigmoidf_(v1[j]); } }
                    u32x4 w; w.x = pk2(v0[0], v0[1]); w.y = pk2(v0[2], v0[3]); w.z = pk2(v1[0], v1[1]); w.w = pk2(v1[2], v1[3]);
                    *(u32x4*)(rowp + bj * 128) = w; } }
    }
};
template <int MODE> struct EpiGate {
    static constexpr bool PERM = true, AFTER_DRAIN = false;
    const bf16_t* gates; int gcol0; const bf16_t* prev; bf16_t* out;
    __device__ __forceinline__ void operator()(const f32x4 (&acc)[2][2][4][2], const pg8::Unit& u, int wr, int wc, int fr, int fq) const {
        const int row0 = u.pm * 256 + wr * 64 + fr, col0 = u.pn * 256 + wc * 32 + 8 * fq;
#pragma unroll
        for (int ai = 0; ai < 2; ++ai)
#pragma unroll
            for (int m = 0; m < 4; ++m) { const int row = row0 + ai * 128 + m * 16;
#pragma unroll
                for (int bj = 0; bj < 2; ++bj) { const int col = col0 + bj * 128;
                    const u32x4 gv = *(const u32x4*)(gates + (size_t)row * 2048 + gcol0 + col);
                    float o[8];
                    o[0] = bflo(gv.x) * acc[ai][bj][m][0][0]; o[1] = bfhi(gv.x) * acc[ai][bj][m][0][1]; o[2] = bflo(gv.y) * acc[ai][bj][m][0][2]; o[3] = bfhi(gv.y) * acc[ai][bj][m][0][3];
                    o[4] = bflo(gv.z) * acc[ai][bj][m][1][0]; o[5] = bfhi(gv.z) * acc[ai][bj][m][1][1]; o[6] = bflo(gv.w) * acc[ai][bj][m][1][2]; o[7] = bfhi(gv.w) * acc[ai][bj][m][1][3];
                    if (MODE == 1) { const u32x4 pv = *(const u32x4*)(prev + (size_t)row * 1024 + col);
                        o[0] += bflo(pv.x); o[1] += bfhi(pv.x); o[2] += bflo(pv.y); o[3] += bfhi(pv.y); o[4] += bflo(pv.z); o[5] += bfhi(pv.z); o[6] += bflo(pv.w); o[7] += bfhi(pv.w); }
                    u32x4 w; w.x = pk2(o[0], o[1]); w.y = pk2(o[2], o[3]); w.z = pk2(o[4], o[5]); w.w = pk2(o[6], o[7]);
                    *(u32x4*)(out + (size_t)row * 1024 + col) = w; }
                asm volatile("" ::: "memory"); }
    }
};
template <bool WRITE_BF> struct EpiRes {
    static constexpr bool PERM = false, AFTER_DRAIN = false;
    const float* base; float* xo; bf16_t* xbo; float* ssq;
    __device__ __forceinline__ void operator()(const f32x4 (&acc)[2][2][4][2], const pg8::Unit& u, int wr, int wc, int fr, int fq) const {
        const int row0 = u.pm * 256 + wr * 64 + fr, col0 = u.pn * 256 + wc * 32 + 4 * fq;
#pragma unroll
        for (int ai = 0; ai < 2; ++ai)
#pragma unroll
            for (int m = 0; m < 4; ++m) { const int row = row0 + ai * 128 + m * 16; const size_t off = (size_t)row * 1024 + col0; float s = 0.f;
#pragma unroll
                for (int bj = 0; bj < 2; ++bj)
#pragma unroll
                    for (int n = 0; n < 2; ++n) { const size_t o = off + bj * 128 + n * 16; const f32x4 v = *(const f32x4*)(base + o) + acc[ai][bj][m][n];
                        *(f32x4*)(xo + o) = v; s += (v.x * v.x + v.y * v.y) + (v.z * v.z + v.w * v.w);
                        if (WRITE_BF) { u32x2 w; w.x = pk2(v.x, v.y); w.y = pk2(v.z, v.w); *(u32x2*)(xbo + o) = w; } }
                s += __shfl_xor(s, 16); s += __shfl_xor(s, 32);
                if (fq == 0) atomicAdd(ssq + row, s);
                asm volatile("" ::: "memory"); }
    }
};
struct EpiUp {
    static constexpr bool PERM = true, AFTER_DRAIN = false;
    const float* ssq; bf16_t* out;
    __device__ __forceinline__ void operator()(const f32x4 (&acc)[2][2][4][2], const pg8::Unit& u, int wr, int wc, int fr, int fq) const {
        const int row0 = u.pm * 256 + wr * 64 + fr, col0 = u.pn * 256 + wc * 32 + 8 * fq;
#pragma unroll
        for (int ai = 0; ai < 2; ++ai)
#pragma unroll
            for (int m = 0; m < 4; ++m) { const int row = row0 + ai * 128 + m * 16; const float rs = rsqrtf(ssq[row] * (1.0f / D) + EPS);
#pragma unroll
                for (int bj = 0; bj < 2; ++bj) { const f32x4 v0 = acc[ai][bj][m][0] * rs, v1 = acc[ai][bj][m][1] * rs;
                    u32x4 w; w.x = pk2(v0[0], v0[1]); w.y = pk2(v0[2], v0[3]); w.z = pk2(v1[0], v1[1]); w.w = pk2(v1[2], v1[3]);
                    *(u32x4*)(out + (size_t)row * DFF + col0 + bj * 128) = w; } }
    }
};

template <int MODE>
__device__ __forceinline__ void gla_unit(LAS unsigned char* lds, int uid, const Params& P, int tid, int lane, int wave) {
    unsigned char* ws = P.ws;
    const float* zgk = (const float*)(ws + WS_ZGK);
    const bf16_t* q = (const bf16_t*)(ws + WS_Q); const bf16_t* k = (const bf16_t*)(ws + WS_K); bf16_t* v = (bf16_t*)(ws + WS_V);
    bf16_t* kvT = (bf16_t*)P.out; float* dvec = (float*)(ws + WS_DVEC); const bf16_t* ogs = (const bf16_t*)(ws + WS_OG);
    const int h = uid & 3, n = (uid >> 2) & 31, b = uid >> 7, t0 = b * 2048 + n * 64;
    const int kk = tid & 127, sg = tid >> 7, l15 = lane & 15, quad = lane >> 4;
    LAS float* Lz = (LAS float*)(lds + L_ZGK); LAS float* Ltot = (LAS float*)(lds + L_TOT);
    bf16_t* stbase = kvT + (size_t)((b * 4 + h) * 32 + n) * 32768;
    __syncthreads();
    if (tid < 256) ((LAS f32x4*)Lz)[tid] = ((const f32x4*)(zgk + (size_t)t0 * 16))[tid];
    {
        const int vcol = tid & 255, sh = tid >> 8; const bf16_t* vp = v + (size_t)(t0 + sh * 32) * 1024 + h * 256 + vcol;
        unsigned pk[16];
#pragma unroll
        for (int i = 0; i < 16; ++i) { const unsigned lo = vp[(size_t)(2 * i) * 1024], hi = vp[(size_t)(2 * i + 1) * 1024]; pk[i] = lo | (hi << 16); }
        LAS u32x4* d = (LAS u32x4*)(lds + L_VT + vcol * 144 + sh * 64);
#pragma unroll
        for (int j = 0; j < 4; ++j) d[j] = (u32x4){pk[4 * j], pk[4 * j + 1], pk[4 * j + 2], pk[4 * j + 3]};
    }
    float la[16];
    {
        float w[16];
#pragma unroll
        for (int r = 0; r < 16; ++r) w[r] = P.w_gk_up[r * 512 + h * 128 + kk];
        const float bb = P.b_gk[h * 128 + kk];
        __syncthreads();
#pragma unroll
        for (int i = 0; i < 16; ++i) {
            const LAS f32x4* zr = (const LAS f32x4*)(Lz + (sg * 16 + i) * 16); const f32x4 z0 = zr[0], z1 = zr[1], z2 = zr[2], z3 = zr[3];
            float xg = bb;
            xg += z0.x * w[0]; xg += z0.y * w[1]; xg += z0.z * w[2]; xg += z0.w * w[3]; xg += z1.x * w[4]; xg += z1.y * w[5]; xg += z1.z * w[6]; xg += z1.w * w[7];
            xg += z2.x * w[8]; xg += z2.y * w[9]; xg += z2.z * w[10]; xg += z2.w * w[11]; xg += z3.x * w[12]; xg += z3.y * w[13]; xg += z3.z * w[14]; xg += z3.w * w[15];
            const float ls = fminf(xg, 0.f) - __logf(1.0f + __expf(-fabsf(xg)));
            la[i] = ls * 0.0625f;
        }
    }
#pragma unroll
    for (int i = 1; i < 16; ++i) la[i] += la[i - 1];
    Ltot[sg * 128 + kk] = la[15];
    __syncthreads();
    const float ts0 = Ltot[kk], ts1 = Ltot[128 + kk], ts2 = Ltot[256 + kk], ts3 = Ltot[384 + kk];
    const float off = (sg > 0 ? ts0 : 0.f) + (sg > 1 ? ts1 : 0.f) + (sg > 2 ? ts2 : 0.f), blast = (ts0 + ts1) + (ts2 + ts3);
    if (MODE == 0) {
        const bf16_t* kp = k + (size_t)(t0 + sg * 16) * 512 + h * 128 + kk;
        unsigned pk[8];
#pragma unroll
        for (int i = 0; i < 8; ++i) {
            const float k0 = bf2f(kp[(size_t)(2 * i) * 512]) * __expf(blast - (la[2 * i] + off)), k1 = bf2f(kp[(size_t)(2 * i + 1) * 512]) * __expf(blast - (la[2 * i + 1] + off));
            pk[i] = pk2(k0, k1);
        }
        LAS u32x4* d = (LAS u32x4*)(lds + L_KD + kk * 144 + sg * 32);
        d[0] = (u32x4){pk[0], pk[1], pk[2], pk[3]}; d[1] = (u32x4){pk[4], pk[5], pk[6], pk[7]};
        if (sg == 0) dvec[(size_t)uid * 128 + kk] = __expf(blast);
        __syncthreads();
        f32x4 acc[2][8];
#pragma unroll
        for (int mt = 0; mt < 2; ++mt)
#pragma unroll
            for (int nt = 0; nt < 8; ++nt) acc[mt][nt] = (f32x4){0.f, 0.f, 0.f, 0.f};
#pragma unroll
        for (int ks = 0; ks < 2; ++ks) {
            bf16x8 bv[2];
#pragma unroll
            for (int mt = 0; mt < 2; ++mt) bv[mt] = *(const LAS bf16x8*)(lds + L_VT + ((2 * wave + mt) * 16 + l15) * 144 + ks * 64 + quad * 16);
#pragma unroll
            for (int nt = 0; nt < 8; ++nt) {
                const bf16x8 a = *(const LAS bf16x8*)(lds + L_KD + (nt * 16 + l15) * 144 + ks * 64 + quad * 16);
#pragma unroll
                for (int mt = 0; mt < 2; ++mt) acc[mt][nt] = MFMA16(a, bv[mt], acc[mt][nt]);
            }
        }
#pragma unroll
        for (int mt = 0; mt < 2; ++mt)
#pragma unroll
            for (int nt = 0; nt < 8; ++nt) { u32x2 o; o.x = pk2(acc[mt][nt][0], acc[mt][nt][1]); o.y = pk2(acc[mt][nt][2], acc[mt][nt][3]);
                *(u32x2*)(stbase + ((2 * wave + mt) * 16 + l15) * 128 + nt * 16 + quad * 4) = o; }
    } else {
        const bf16_t* qp = q + (size_t)(t0 + sg * 16) * 512 + h * 128 + kk; const bf16_t* kp = k + (size_t)(t0 + sg * 16) * 512 + h * 128 + kk;
        LAS bf16_t* QF = (LAS bf16_t*)(lds + L_QF); LAS bf16_t* QB = (LAS bf16_t*)(lds + L_QB); LAS bf16_t* KF = (LAS bf16_t*)(lds + L_KF); LAS bf16_t* KB = (LAS bf16_t*)(lds + L_KB);
#pragma unroll
        for (int i = 0; i < 16; ++i) {
            const int s = sg * 16 + i; const float bc = la[i] + off, ep = __expf(bc), en = __expf(-bc);
            const float qv = bf2f(qp[(size_t)i * 512]), kv = bf2f(kp[(size_t)i * 512]);
            QF[s * 136 + kk] = f2bf(qv * ep); QB[s * 136 + kk] = f2bf(qv * en); KF[s * 136 + kk] = f2bf(kv * en); KB[s * 136 + kk] = f2bf(kv * ep);
        }
        bf16x8 stf[2][4];
#pragma unroll
        for (int vt = 0; vt < 2; ++vt)
#pragma unroll
            for (int ks = 0; ks < 4; ++ks) stf[vt][ks] = *(const bf16x8*)(stbase + ((2 * wave + vt) * 16 + l15) * 128 + ks * 32 + quad * 8);
        __syncthreads();
        {
            const int tt = wave >> 1;
#pragma unroll
            for (int sti = 0; sti < 2; ++sti) {
                const int st = (wave & 1) * 2 + sti; f32x4 fw = (f32x4){0.f, 0.f, 0.f, 0.f}, bw = (f32x4){0.f, 0.f, 0.f, 0.f};
#pragma unroll
                for (int ks = 0; ks < 4; ++ks) {
                    const int oa = (st * 16 + l15) * 272 + ks * 64 + quad * 16, ob_ = (tt * 16 + l15) * 272 + ks * 64 + quad * 16;
                    fw = MFMA16(*(const LAS bf16x8*)(lds + L_KF + oa), *(const LAS bf16x8*)(lds + L_QF + ob_), fw);
                    bw = MFMA16(*(const LAS bf16x8*)(lds + L_KB + oa), *(const LAS bf16x8*)(lds + L_QB + ob_), bw);
                }
                const int t = tt * 16 + l15, s0 = st * 16 + quad * 4;
                float p[4];
#pragma unroll
                for (int r = 0; r < 4; ++r) p[r] = (s0 + r <= t) ? fw[r] : bw[r];
                u32x2 o; o.x = pk2(p[0], p[1]); o.y = pk2(p[2], p[3]);
                *(LAS u32x2*)(lds + L_P + t * 144 + s0 * 2) = o;
            }
        }
        __syncthreads();
        f32x4 acc[2][4];
#pragma unroll
        for (int vt = 0; vt < 2; ++vt)
#pragma unroll
            for (int tt = 0; tt < 4; ++tt) acc[vt][tt] = (f32x4){0.f, 0.f, 0.f, 0.f};
#pragma unroll
        for (int ks = 0; ks < 2; ++ks) {
            bf16x8 av[2];
#pragma unroll
            for (int vt = 0; vt < 2; ++vt) av[vt] = *(const LAS bf16x8*)(lds + L_VT + ((2 * wave + vt) * 16 + l15) * 144 + ks * 64 + quad * 16);
#pragma unroll
            for (int tt = 0; tt < 4; ++tt) { const bf16x8 bp = *(const LAS bf16x8*)(lds + L_P + (tt * 16 + l15) * 144 + ks * 64 + quad * 16);
#pragma unroll
                for (int vt = 0; vt < 2; ++vt) acc[vt][tt] = MFMA16(av[vt], bp, acc[vt][tt]); }
        }
#pragma unroll
        for (int ks = 0; ks < 4; ++ks)
#pragma unroll
            for (int tt = 0; tt < 4; ++tt) { const bf16x8 bq = *(const LAS bf16x8*)(lds + L_QF + (tt * 16 + l15) * 272 + ks * 64 + quad * 16);
#pragma unroll
                for (int vt = 0; vt < 2; ++vt) acc[vt][tt] = MFMA16(stf[vt][ks], bq, acc[vt][tt]); }
        LAS float* Lred = (LAS float*)(lds + L_RED);
#pragma unroll
        for (int tt = 0; tt < 4; ++tt) {
            float s = 0.f;
#pragma unroll
            for (int vt = 0; vt < 2; ++vt) s += (acc[vt][tt][0] * acc[vt][tt][0] + acc[vt][tt][1] * acc[vt][tt][1]) + (acc[vt][tt][2] * acc[vt][tt][2] + acc[vt][tt][3] * acc[vt][tt][3]);
            s += __shfl_xor(s, 16); s += __shfl_xor(s, 32);
            if (quad == 0) Lred[wave * 64 + tt * 16 + l15] = s;
        }
        __syncthreads();
#pragma unroll
        for (int tt = 0; tt < 4; ++tt) {
            const int t = tt * 16 + l15; float tot = 0.f;
#pragma unroll
            for (int w8 = 0; w8 < 8; ++w8) tot += Lred[w8 * 64 + t];
            const float rs = rsqrtf(tot * (1.0f / 256.0f) + EPS);
#pragma unroll
            for (int vt = 0; vt < 2; ++vt) {
                const size_t o = (size_t)(t0 + t) * 1024 + h * 256 + (2 * wave + vt) * 16 + quad * 4;
                const u32x2 gv = *(const u32x2*)(ogs + o);
                u32x2 w; w.x = pk2(acc[vt][tt][0] * rs * bflo(gv.x), acc[vt][tt][1] * rs * bfhi(gv.x)); w.y = pk2(acc[vt][tt][2] * rs * bflo(gv.y), acc[vt][tt][3] * rs * bfhi(gv.y));
                *(u32x2*)(v + o) = w;
            }
        }
    }
}

__global__ void __launch_bounds__(512, 2) fwd_megakernel(Params P) {
    extern __shared__ __attribute__((aligned(16))) unsigned char lds_raw[];
    LAS unsigned char* lds = (LAS unsigned char*)lds_raw;
    cg::grid_group grid = cg::this_grid();
    const int tid = threadIdx.x, lane = tid & 63, wave = __builtin_amdgcn_readfirstlane(tid >> 6);
    const int G = gridDim.x, bid = blockIdx.x;
    const size_t gtid = (size_t)bid * 512 + tid, gsz = (size_t)G * 512;
    unsigned char* ws = P.ws;

#define IN(k) (P.ph_lo <= (k) && (k) < P.ph_hi)
#define SEAM(k) do { if (IN(k) && IN((k) + 1)) GRID_SYNC(); } while (0)
    if (IN(0)) p0_prologue(P, lds, tid, lane, wave);
    SEAM(0);

    if (IN(1)) { pg8::Gemm g{(const bf16_t*)(ws + WS_XB), (const bf16_t*)(ws + WS_WIN), T, NIN, D}; pg8::StaticOrder S; S.init(T, NIN, G, bid);
      EpiIn E{ws, P.b_gate}; pg8::gemm_phase<EpiIn, pg8::StaticOrder, false>(lds, g, S, E, nullptr); }
    SEAM(1);

    if (IN(2)) {
        const unsigned* zp = (const unsigned*)(ws + WS_ZPOOL); unsigned* pp = (unsigned*)(ws + WS_XB);
        for (size_t idx = gtid; idx < (size_t)512 * 256; idx += gsz) {
            const int cp = (int)(idx & 255), tb = (int)(idx >> 8), t0 = tb * 32, pos0 = t0 & 2047, w = 2 << (cp >> 6);
            float s0 = 0.f, s1 = 0.f;
            for (int i = 1; i < w; ++i) if (pos0 - i >= 0) { const unsigned uu = zp[(size_t)(t0 - i) * 256 + cp]; s0 += bflo(uu); s1 += bfhi(uu); }
            for (int tt = 0; tt < 32; ++tt) {
                const int t = t0 + tt, pos = pos0 + tt; const unsigned uu = zp[(size_t)t * 256 + cp]; const float a0 = bflo(uu), a1 = bfhi(uu);
                s0 += a0; s1 += a1;
                const float inv = 1.0f / (float)min(pos + 1, w);
                pp[(size_t)t * 256 + cp] = pk2(s0 * inv - a0, s1 * inv - a1);
                if (pos - (w - 1) >= 0) { const unsigned uo = zp[(size_t)(t - (w - 1)) * 256 + cp]; s0 -= bflo(uo); s1 -= bfhi(uo); }
            }
        }
        for (int uid = bid; uid < 1024; uid += G) gla_unit<0>(lds, uid, P, tid, lane, wave);
    }
    SEAM(2);

    if (IN(3)) {
        bf16_t* kvT = (bf16_t*)P.out; const float* dvec = (const float*)(ws + WS_DVEC);
        for (size_t e = gtid; e < 131072; e += gsz) {
            const int bh = (int)(e >> 12), vec = (int)(e & 4095), b = bh >> 2, h = bh & 3, kk0 = (vec * 8) & 127;
            float S[8];
#pragma unroll
            for (int j = 0; j < 8; ++j) S[j] = 0.f;
#pragma unroll 4
            for (int n = 0; n < 32; ++n) {
                u32x4* ptr = (u32x4*)(kvT + (size_t)(bh * 32 + n) * 32768 + (size_t)vec * 8);
                const float* dp = dvec + (size_t)(b * 128 + n * 4 + h) * 128 + kk0;
                const u32x4 kv = *ptr; const f32x4 d0 = *(const f32x4*)dp, d1 = *(const f32x4*)(dp + 4);
                u32x4 o; o.x = pk2(S[0], S[1]); o.y = pk2(S[2], S[3]); o.z = pk2(S[4], S[5]); o.w = pk2(S[6], S[7]);
                *ptr = o;
                S[0] = d0.x * S[0] + bflo(kv.x); S[1] = d0.y * S[1] + bfhi(kv.x); S[2] = d0.z * S[2] + bflo(kv.y); S[3] = d0.w * S[3] + bfhi(kv.y);
                S[4] = d1.x * S[4] + bflo(kv.z); S[5] = d1.y * S[5] + bfhi(kv.z); S[6] = d1.z * S[6] + bflo(kv.w); S[7] = d1.w * S[7] + bfhi(kv.w);
            }
        }
    }
    SEAM(3);

    if (IN(4)) for (int uid = bid; uid < 1024; uid += G) gla_unit<1>(lds, uid, P, tid, lane, wave);
    SEAM(4);

    if (IN(5)) {
    { pg8::Gemm g{(const bf16_t*)(ws + WS_XB), (const bf16_t*)(ws + WS_WEFF), T, D, 512}; pg8::StaticOrder S; S.init(T, D, G, bid);
      EpiGate<0> E{(const bf16_t*)(ws + WS_GATES), 0, nullptr, (bf16_t*)(ws + WS_YPG)}; pg8::gemm_phase<EpiGate<0>, pg8::StaticOrder, false>(lds, g, S, E, nullptr); }
    __syncthreads();
    { pg8::Gemm g{(const bf16_t*)(ws + WS_V), (const bf16_t*)(ws + WS_WGP), T, D, D}; pg8::StaticOrder S; S.init(T, D, G, bid);
      EpiGate<1> E{(const bf16_t*)(ws + WS_GATES), 1024, (const bf16_t*)(ws + WS_YPG), (bf16_t*)(ws + WS_MIXED)}; pg8::gemm_phase<EpiGate<1>, pg8::StaticOrder, false>(lds, g, S, E, nullptr); }
    }
    SEAM(5);

    if (IN(6)) { pg8::Gemm g{(const bf16_t*)(ws + WS_MIXED), (const bf16_t*)(ws + WS_WOUT), T, D, D}; pg8::StaticOrder S; S.init(T, D, G, bid);
      EpiRes<true> E{P.x, P.out, (bf16_t*)(ws + WS_XB), (float*)(ws + WS_SSQ2)}; pg8::gemm_phase<EpiRes<true>, pg8::StaticOrder, false>(lds, g, S, E, nullptr); }
    SEAM(6);

    for (int hf = 0; hf < 2; ++hf) {
        if (IN(7 + 2 * hf)) { pg8::Gemm g{(const bf16_t*)(ws + WS_XB), (const bf16_t*)(ws + WS_WUP) + (size_t)hf * DFF * D, T, DFF, D}; pg8::StaticOrder S; S.init(T, DFF, G, bid);
          EpiUp E{(const float*)(ws + WS_SSQ2), (bf16_t*)(ws + WS_UH)}; pg8::gemm_phase<EpiUp, pg8::StaticOrder, false>(lds, g, S, E, nullptr); }
        SEAM(7 + 2 * hf);
        if (IN(8 + 2 * hf)) {
            const bf16_t* uh = (const bf16_t*)(ws + WS_UH); unsigned* ao = (unsigned*)(ws + WS_A);
            for (size_t idx = gtid; idx < (size_t)512 * 704; idx += gsz) {
                const int cp = (int)(idx % 704), tb = (int)(idx / 704), t0 = tb * 32, pos0 = t0 & 2047;
                const int chl = 2 * cp, gcol = 256 * (chl >> 7) + (chl & 127), ch = 1408 * hf + chl;
                const unsigned* ug = (const unsigned*)(uh + gcol); const unsigned* uv = (const unsigned*)(uh + gcol + 128);
                float wg[3][2], wv[3][2];
#pragma unroll
                for (int j = 0; j < 3; ++j) { wg[j][0] = P.w_conv[j * 5632 + ch]; wg[j][1] = P.w_conv[j * 5632 + ch + 1]; wv[j][0] = P.w_conv[j * 5632 + 2816 + ch]; wv[j][1] = P.w_conv[j * 5632 + 2816 + ch + 1]; }
                const float bg0 = P.b_conv[ch], bg1 = P.b_conv[ch + 1], bv0 = P.b_conv[2816 + ch], bv1 = P.b_conv[2816 + ch + 1];
                unsigned g2 = 0, g1 = 0, v2 = 0, v1 = 0;
                if (pos0 >= 2) { g2 = ug[(size_t)(t0 - 2) * 1408]; g1 = ug[(size_t)(t0 - 1) * 1408]; v2 = uv[(size_t)(t0 - 2) * 1408]; v1 = uv[(size_t)(t0 - 1) * 1408]; }
                for (int tt = 0; tt < 32; ++tt) {
                    const int t = t0 + tt; const unsigned g0 = ug[(size_t)t * 1408], v0 = uv[(size_t)t * 1408];
                    const float cg0 = bg0 + wg[0][0] * bflo(g2) + wg[1][0] * bflo(g1) + wg[2][0] * bflo(g0), cg1 = bg1 + wg[0][1] * bfhi(g2) + wg[1][1] * bfhi(g1) + wg[2][1] * bfhi(g0);
                    const float cv0 = bv0 + wv[0][0] * bflo(v2) + wv[1][0] * bflo(v1) + wv[2][0] * bflo(v0), cv1 = bv1 + wv[0][1] * bfhi(v2) + wv[1][1] * bfhi(v1) + wv[2][1] * bfhi(v0);
                    ao[((size_t)t * DFF + ch) >> 1] = pk2(cg0 * sigmoidf_(cg0) * cv0, cg1 * sigmoidf_(cg1) * cv1);
                    g2 = g1; g1 = g0; v2 = v1; v1 = v0;
                }
            }
        }
        SEAM(8 + 2 * hf);
    }

    if (IN(11)) { pg8::Gemm g{(const bf16_t*)(ws + WS_A), (const bf16_t*)(ws + WS_WDOWN), T, D, DFF}; pg8::StaticOrder S; S.init(T, D, G, bid);
      EpiRes<false> E{P.out, P.out, nullptr, (float*)(ws + WS_SSQ3)}; pg8::gemm_phase<EpiRes<false>, pg8::StaticOrder, false>(lds, g, S, E, nullptr); }
    SEAM(11);

    if (P.ph_lo == 101) {
        const bf16_t* zp = (const bf16_t*)(ws + WS_ZPOOL); const bf16_t* q = (const bf16_t*)(ws + WS_Q); const bf16_t* k = (const bf16_t*)(ws + WS_K); const bf16_t* v = (const bf16_t*)(ws + WS_V);
        const bf16_t* og = (const bf16_t*)(ws + WS_OG); const bf16_t* ga = (const bf16_t*)(ws + WS_GATES); const float* zgk = (const float*)(ws + WS_ZGK); const float* r1 = (const float*)(ws + WS_RSTD1);
        for (size_t i = gtid; i < (size_t)T * 1024; i += gsz) { const size_t t = i >> 10, c = i & 1023;
            P.out[i] = bf2f(zp[t * 512 + (c & 511)]) + bf2f(q[t * 512 + (c & 511)]) + bf2f(k[t * 512 + (c & 511)]) + bf2f(v[i]) + bf2f(og[i]) + bf2f(ga[t * 2048 + c]) + bf2f(ga[t * 2048 + 1024 + c]) + zgk[t * 16 + (c & 15)] + r1[t]; }
    }
    if (P.ph_lo == 102) {
        const bf16_t* xb = (const bf16_t*)(ws + WS_XB); const bf16_t* w1 = (const bf16_t*)(ws + WS_WIN); const bf16_t* w2 = (const bf16_t*)(ws + WS_WUP); const bf16_t* w3 = (const bf16_t*)(ws + WS_WDOWN);
        const bf16_t* w4 = (const bf16_t*)(ws + WS_WGP); const bf16_t* w5 = (const bf16_t*)(ws + WS_WOUT); const bf16_t* w6 = (const bf16_t*)(ws + WS_WEFF);
        for (size_t i = gtid; i < (size_t)T * 1024; i += gsz)
            P.out[i] = bf2f(xb[i]) + bf2f(w1[i % ((size_t)5888 * 1024)]) + bf2f(w2[i % ((size_t)5632 * 1024)]) + bf2f(w3[i % ((size_t)1024 * 2816)]) + bf2f(w4[i & 1048575]) + bf2f(w5[i & 1048575]) + bf2f(w6[i & 524287]);
    }
    if (P.ph_lo == 110) {
        const bf16_t* kv = (const bf16_t*)P.out; float* red = (float*)(ws + WS_XB + 16 * MiB); const float* dv = (const float*)(ws + WS_DVEC);
        for (size_t g = gtid; g < 131072; g += gsz) { float s = dv[g]; for (int j = 0; j < 256; ++j) s += bf2f(kv[g + (size_t)j * 131072]); red[g] = s; }
    }
    if (P.ph_lo == 111) {
        const float* red = (const float*)(ws + WS_XB + 16 * MiB); const bf16_t* pp = (const bf16_t*)(ws + WS_XB);
        for (size_t i = gtid; i < (size_t)T * 1024; i += gsz) { const size_t t = i >> 10, c = i & 1023; float vv = red[i & 131071] * (MK_DUMPSEL & 1 ? 1.f : 0.f) + bf2f(pp[t * 512 + (c & 511)]) * (MK_DUMPSEL & 2 ? 1.f : 0.f); if (!(fabsf(vv) < 1e30f)) vv = 777.f; P.out[i] = vv; }
    }
    if (P.ph_lo == 104) {
        const bf16_t* ob = (const bf16_t*)(ws + WS_V); const bf16_t* pp = (const bf16_t*)(ws + WS_XB);
        for (size_t i = gtid; i < (size_t)T * 1024; i += gsz) { const size_t t = i >> 10, c = i & 1023; P.out[i] = bf2f(ob[i]) + bf2f(pp[t * 512 + (c & 511)]); }
    }
    if (IN(12)) {
        const float* ssq3 = (const float*)(ws + WS_SSQ3); const int gw = bid * 8 + wave, NGW = G * 8;
        for (int m = gw; m < T; m += NGW) {
            const float rs = rsqrtf(ssq3[m] * (1.0f / D) + EPS);
            f32x4* xr = (f32x4*)(P.out + (size_t)m * D) + lane; const f32x4* gr = (const f32x4*)P.g_final + lane;
#pragma unroll
            for (int j = 0; j < 4; ++j) xr[64 * j] = xr[64 * j] * rs * gr[64 * j];
        }
    }
}

extern "C" void kernel_launch(void* const* d_in, const int* in_sizes, int n_in, void* d_out, int out_size, void* d_ws, size_t ws_size, hipStream_t stream) {
    static int grid = 0;
    if (grid == 0) {
        int dev = 0, cus = 0, per_cu = 0;
        (void)hipGetDevice(&dev);
        (void)hipDeviceGetAttribute(&cus, hipDeviceAttributeMultiprocessorCount, dev);
        (void)hipFuncSetAttribute((const void*)fwd_megakernel, hipFuncAttributeMaxDynamicSharedMemorySize, LDS_BYTES);
        (void)hipOccupancyMaxActiveBlocksPerMultiprocessor(&per_cu, (const void*)fwd_megakernel, 512, LDS_BYTES);
        if (per_cu < 1) fprintf(stderr, "kernel_launch: occupancy query says %d blocks per CU\n", per_cu);
        (void)hipGetLastError();
        grid = cus > 0 ? cus : 256;
    }
    Params p{};
    const float** pp = (const float**)&p;
    for (int i = 0; i < 18; ++i) pp[i] = (const float*)d_in[i];
    p.out = (float*)d_out; p.ws = (unsigned char*)d_ws;
#if MK_PER_PHASE
    for (int ph = 0; ph < MK_NPH; ++ph) { p.ph_lo = ph; p.ph_hi = ph + 1; hipLaunchKernelGGL(fwd_megakernel, dim3(grid), dim3(512), LDS_BYTES, stream, p); }
#ifdef MK_DUMP
    p.ph_lo = MK_DUMP; p.ph_hi = MK_DUMP + 1; hipLaunchKernelGGL(fwd_megakernel, dim3(grid), dim3(512), LDS_BYTES, stream, p);
    if (MK_DUMP == 110) { p.ph_lo = 111; p.ph_hi = 112; hipLaunchKernelGGL(fwd_megakernel, dim3(grid), dim3(512), LDS_BYTES, stream, p); }
#endif
#else
    p.ph_lo = 0; p.ph_hi = 13;
    void* args[] = {&p};
    hipError_t e = hipLaunchCooperativeKernel((void*)fwd_megakernel, dim3(grid), dim3(512), args, LDS_BYTES, stream);
    if (e != hipSuccess) fprintf(stderr, "cooperative launch failed: %s (grid %d)\n", hipGetErrorString(e), grid);
#endif
}
```

```cpp
#include <hip/hip_runtime.h>
#include <hip/hip_cooperative_groups.h>
#include <cstdio>
namespace cg = cooperative_groups;
namespace pg8 {
#define PG8_LAS __attribute__((address_space(3)))
typedef unsigned short bf16_t;
typedef short bf16x8 __attribute__((ext_vector_type(8)));
typedef float f32x4 __attribute__((ext_vector_type(4)));
typedef unsigned u32x4 __attribute__((ext_vector_type(4)));
constexpr int BM = 256, BK = 64, HALF = 128, HTB = HALF * BK * 2  , STAGE_BYTES = 8 * HTB, NXCD = 8, WGM = 8;

__host__ __device__ __forceinline__ int lds_byte(int r, int c) { const int st = (r >> 4) * 2 + (c >> 5), rr = r & 15, cc = c & 31, ob = rr * 64 + cc * 2; return st * 1024 + (ob ^ (((ob >> 9) & 1) << 5)); }
__host__ __device__ __forceinline__ void stage_rc(int b, int& R, int& C) { const int st = b / 1024, sb = b % 1024, swz = sb ^ (((sb >> 9) & 1) << 5); R = (st >> 1) * 16 + swz / 64; C = (st & 1) * 32 + (swz % 64) / 2; }
__host__ __device__ __forceinline__ int perm32(int rho) { const int n = rho >> 4, i = rho & 15; return 8 * (i >> 2) + 4 * n + (i & 3); }

struct Unit { int pm, pn; };
struct Gemm { const bf16_t* A; const bf16_t* Bt; int M, N, K; };

struct StaticOrder {
    int nM, nN, nwg, G, c;
    __host__ __device__ void init(int M, int N, int G_, int c_) { nM = M / BM; nN = N / BM; nwg = nM * nN; G = G_; c = c_; }
    __host__ __device__ bool next(int i, Unit& u) const {
        const long L = (long)i * G + c; if (L >= nwg) return false;
        int wgid = (int)L; { const int q = nwg / NXCD, r = nwg % NXCD, xcd = wgid % NXCD, off = wgid / NXCD; wgid = (xcd < r ? xcd * (q + 1) : r * (q + 1) + (xcd - r) * q) + off; }
        const int nig = WGM * nN, gid = wgid / nig, fm = gid * WGM, gsz = (nM - fm) < WGM ? (nM - fm) : WGM;
        u.pm = fm + ((wgid % nig) % gsz); u.pn = (wgid % nig) / gsz; return true;
    }
    __device__ __forceinline__ void a_ready(const Unit&) const {}
    __device__ __forceinline__ void done(const Unit&) const {}
};
typedef float f32x2 __attribute__((ext_vector_type(2)));
typedef __bf16 bf16x2_t __attribute__((ext_vector_type(2)));
__device__ __forceinline__ unsigned cvt_pk_bf16(float lo, float hi) { const f32x2 v = {lo, hi}; const bf16x2_t r = __builtin_convertvector(v, bf16x2_t); return __builtin_bit_cast(unsigned, r); }
template <class Epi, class Sched, bool STAMP = false>
__device__ __forceinline__ void gemm_phase(PG8_LAS unsigned char* lds, const Gemm g, const Sched& S, const Epi& E, unsigned long long* stamps, const int tid_in) {
    const int tid = tid_in, wid = __builtin_amdgcn_readfirstlane(tid >> 6), lane = tid & 63, wr = wid >> 2, wc = wid & 3, fr = lane & 15, fq = lane >> 4;
    const int K = g.K, nt = K / BK;
    int ts_lo = 0, ts_hi = 0, nts = 0; const unsigned long long rt_entry = STAMP ? (unsigned long long)wall_clock64() : 0ull;
#define PG8_STAMP() do { if (STAMP && wid == 0 && nts < 64) { const unsigned long long _c = (unsigned long long)clock64(); \
        ts_lo = (lane == nts) ? (int)(unsigned)_c : ts_lo; ts_hi = (lane == nts) ? (int)(unsigned)(_c >> 32) : ts_hi; ++nts; } } while (0)
    PG8_STAMP();
    unsigned voffA[2], voffB[2];
#pragma unroll
    for (int i = 0; i < 2; ++i) { int R, C; stage_rc(tid * 16 + i * 8192, R, C); const int Rb = Epi::PERM ? ((R & ~31) + perm32(R & 31)) : R;
        voffA[i] = (unsigned)(R * K + C) * 2u; voffB[i] = (unsigned)(Rb * K + C) * 2u; }
    const size_t kstep = (size_t)(BK * 2);
    const size_t hstep = (size_t)HALF * K * 2;
    const size_t tstep = 2 * hstep;
    const unsigned ldsw = (unsigned)wid * 1024u;
    const int aoff = lds_byte(wr * 64 + fr, fq * 8), boff = lds_byte(wc * 32 + fr, fq * 8);
#define PG8_SA(b, h) (((b) * 2 + (h)) * HTB)
#define PG8_SB(b, h) ((4 + (b) * 2 + (h)) * HTB)
#define PG8_STAGE(bufoff, gbase, voff) do { _Pragma("unroll") for (int _i = 0; _i < 2; ++_i) \
        __builtin_amdgcn_global_load_lds((const unsigned*)((const char*)(gbase) + (voff)[_i]), (PG8_LAS unsigned*)(lds + (bufoff) + ldsw + _i * 8192), 16, 0, 0); } while (0)
#define PG8_LDA(dst, b, h) do { _Pragma("unroll") for (int m = 0; m < 4; ++m) _Pragma("unroll") for (int k = 0; k < 2; ++k) dst[m][k] = *(const PG8_LAS bf16x8*)(lds + PG8_SA(b, h) + aoff + m * 2048 + k * 1024); } while (0)
#define PG8_LDB(dst, b, h) do { _Pragma("unroll") for (int n = 0; n < 2; ++n) _Pragma("unroll") for (int k = 0; k < 2; ++k) dst[n][k] = *(const PG8_LAS bf16x8*)(lds + PG8_SB(b, h) + boff + n * 2048 + k * 1024); } while (0)
#define PG8_MMA(ai, bj, At, Bt) do { __builtin_amdgcn_s_setprio(1); _Pragma("unroll") for (int m = 0; m < 4; ++m) _Pragma("unroll") for (int n = 0; n < 2; ++n) _Pragma("unroll") for (int k = 0; k < 2; ++k) \
        acc[ai][bj][m][n] = __builtin_amdgcn_mfma_f32_16x16x32_bf16(Bt[n][k], At[m][k], acc[ai][bj][m][n], 0, 0, 0); __builtin_amdgcn_s_setprio(0); } while (0)
#define PG8_WAIT_V(n) asm volatile("s_waitcnt vmcnt(" #n ")" ::: "memory")
#define PG8_WAIT_L(n) asm volatile("s_waitcnt lgkmcnt(" #n ")" ::: "memory")
#define PG8_BAR __builtin_amdgcn_s_barrier()
#define PG8_SCHED __builtin_amdgcn_sched_barrier(0)
    Unit cur, nxt; int ui = 0;
    if (!S.next(0, cur)) return;
    f32x4 acc[2][2][4][2];
#pragma unroll
    for (int a = 0; a < 2; ++a)
#pragma unroll
        for (int b = 0; b < 2; ++b)
#pragma unroll
            for (int m = 0; m < 4; ++m)
#pragma unroll
                for (int n = 0; n < 2; ++n) acc[a][b][m][n] = (f32x4){0.f, 0.f, 0.f, 0.f};
    bf16x8 At[4][2], B0[2][2], B1[2][2];
    const char* cA = (const char*)g.A + (size_t)cur.pm * tstep; const char* cB = (const char*)g.Bt + (size_t)cur.pn * tstep;
    S.a_ready(cur);
    PG8_STAGE(PG8_SB(0, 0), cB, voffB); PG8_STAGE(PG8_SA(0, 0), cA, voffA); PG8_STAGE(PG8_SB(0, 1), cB + hstep, voffB); PG8_STAGE(PG8_SA(0, 1), cA + hstep, voffA);
    if (wr == 1) PG8_BAR;
    PG8_WAIT_V(4); PG8_BAR;
    PG8_STAGE(PG8_SB(1, 0), cB + kstep, voffB); PG8_STAGE(PG8_SA(1, 0), cA + kstep, voffA); PG8_STAGE(PG8_SB(1, 1), cB + hstep + kstep, voffB);
    PG8_WAIT_V(6); PG8_BAR;
    PG8_STAMP();
    for (;;) {
        const bool has_next = S.next(ui + 1, nxt);
        const char* nA = has_next ? (const char*)g.A + (size_t)nxt.pm * tstep : cA; const char* nB = has_next ? (const char*)g.Bt + (size_t)nxt.pn * tstep : cB;
        for (int t = 0; t < nt; t += 2) {
            const bool last = (t == nt - 2);
            const char* a1 = cA + (size_t)(t + 1) * kstep;
            const char* a2 = last ? nA : cA + (size_t)(t + 2) * kstep; const char* b2 = last ? nB : cB + (size_t)(t + 2) * kstep;
            const char* a3 = a2 + kstep; const char* b3 = b2 + kstep;
            if (last && has_next) S.a_ready(nxt);
            PG8_LDB(B0, 0, 0); PG8_SCHED; PG8_LDA(At, 0, 0); PG8_STAGE(PG8_SA(1, 1), a1 + hstep, voffA);
            PG8_WAIT_L(8); PG8_BAR; PG8_WAIT_L(0); PG8_MMA(0, 0, At, B0); PG8_BAR; PG8_SCHED;
            PG8_LDB(B1, 0, 1); PG8_STAGE(PG8_SB(0, 0), b2, voffB);
            PG8_BAR; PG8_WAIT_L(0); PG8_MMA(0, 1, At, B1); PG8_BAR;
            PG8_LDA(At, 0, 1); PG8_STAGE(PG8_SA(0, 0), a2, voffA);
            PG8_BAR; PG8_WAIT_L(0); PG8_MMA(1, 0, At, B0); PG8_BAR; PG8_SCHED;
            PG8_STAGE(PG8_SB(0, 1), b2 + hstep, voffB);
            PG8_WAIT_V(6); PG8_BAR; PG8_MMA(1, 1, At, B1); PG8_BAR;
            PG8_LDB(B0, 1, 0); PG8_SCHED; PG8_LDA(At, 1, 0); PG8_STAGE(PG8_SA(0, 1), a2 + hstep, voffA);
            PG8_WAIT_L(8); PG8_BAR; PG8_WAIT_L(0); PG8_MMA(0, 0, At, B0); PG8_BAR; PG8_SCHED;
            PG8_LDB(B1, 1, 1); PG8_STAGE(PG8_SB(1, 0), b3, voffB);
            PG8_BAR; PG8_WAIT_L(0); PG8_MMA(0, 1, At, B1); PG8_BAR;
            PG8_LDA(At, 1, 1); PG8_STAGE(PG8_SA(1, 0), a3, voffA);
            PG8_BAR; PG8_WAIT_L(0); PG8_MMA(1, 0, At, B0); PG8_BAR; PG8_SCHED;
            PG8_STAGE(PG8_SB(1, 1), b3 + hstep, voffB);
            PG8_WAIT_V(6); PG8_BAR; PG8_MMA(1, 1, At, B1); PG8_BAR;
        }
        PG8_STAMP();
        if constexpr (!Epi::AFTER_DRAIN) { E(acc, cur, wr, wc, fr, fq); S.done(cur); }
        PG8_STAMP();
        if (!has_next) break;
#pragma unroll
        for (int a = 0; a < 2; ++a)
#pragma unroll
            for (int b = 0; b < 2; ++b)
#pragma unroll
                for (int m = 0; m < 4; ++m)
#pragma unroll
                    for (int n = 0; n < 2; ++n) acc[a][b][m][n] = (f32x4){0.f, 0.f, 0.f, 0.f};
        cur = nxt; cA = nA; cB = nB; ++ui;
    }
    PG8_WAIT_V(0);
    if (wr == 0) PG8_BAR;
    PG8_BAR;
    if constexpr (Epi::AFTER_DRAIN) { E.fused(acc, cur, wr, wc, fr, fq, lds, wid, lane); S.done(cur); }
    PG8_STAMP();
    if (STAMP && wid == 0) { stamps[lane] = lane < nts ? (((unsigned long long)(unsigned)ts_hi << 32) | (unsigned)ts_lo) : 0ull;
        if (lane == 62) stamps[62] = rt_entry; if (lane == 63) stamps[63] = (unsigned long long)wall_clock64(); }
#undef PG8_STAMP
#undef PG8_SA
#undef PG8_SB
#undef PG8_STAGE
#undef PG8_LDA
#undef PG8_LDB
#undef PG8_MMA
#undef PG8_WAIT_V
#undef PG8_WAIT_L
#undef PG8_BAR
#undef PG8_SCHED
}
}

#define MK_PER_PHASE 0
#define MK_NPH 10
#define MK_DUMPSEL 1
#define MK_REP -1

#define LAS __attribute__((address_space(3)))
using pg8::bf16_t; using pg8::bf16x8; using pg8::f32x4; using pg8::u32x4;
typedef unsigned u32x2 __attribute__((ext_vector_type(2)));
constexpr int T = 16384, D = 1024, NIN = 5888, DFF = 2816;
constexpr float EPS = 1e-6f;
constexpr size_t MiB = 1u << 20;
constexpr size_t WS_WIN = 0, WS_WEFF = 12 * MiB, WS_WGP = 13 * MiB, WS_WOUT = 15 * MiB, WS_WUP = 17 * MiB, WS_WDOWN = 28 * MiB;
constexpr size_t WS_XB = 34 * MiB;
constexpr size_t WS_ZPOOL = 66 * MiB, WS_Q = 82 * MiB, WS_K = 98 * MiB, WS_V = 114 * MiB, WS_OG = 146 * MiB, WS_GATES = 178 * MiB;
constexpr size_t WS_ZGK = 242 * MiB, WS_RSTD1 = 243 * MiB, WS_SSQ2 = WS_RSTD1 + 65536, WS_SSQ3 = WS_SSQ2 + 65536, WS_DVEC = WS_SSQ3 + 65536, WS_BAR = WS_DVEC + MiB;
constexpr size_t WS_YPG = WS_Q, WS_MIXED = WS_OG;
constexpr size_t WS_HBUF = 66 * MiB, WS_PBUF = 80 * MiB, WS_A = 154 * MiB;
constexpr int LDS_BYTES = 131072;
constexpr int L_ZGK = 0, L_TOT = 4096, L_RED = 6144, L_VT = 8192, L_KD = 45056, L_QF = 45056, L_QB = 62464, L_KF = 79872, L_KB = 97280, L_P = 114688;

struct Params {
    const float *x, *g_mix, *w_in, *b_gate, *w_gk_up, *b_gk, *w_pool_grp, *pool_scale, *g_gla_head, *w_pool_proj, *w_gla_proj, *w_out, *g_ffn, *w_up, *w_conv, *b_conv, *w_down, *g_final;
    float* out; unsigned char* ws; int ph_lo, ph_hi;
};

__device__ __forceinline__ unsigned pk2(float lo, float hi) { return pg8::cvt_pk_bf16(lo, hi); }
__device__ __forceinline__ float bf2f(unsigned b) { return __uint_as_float(b << 16); }
__device__ __forceinline__ float bflo(unsigned w) { return __uint_as_float(w << 16); }
__device__ __forceinline__ float bfhi(unsigned w) { return __uint_as_float(w & 0xffff0000u); }
__device__ __forceinline__ bf16_t f2bf(float f) { unsigned u = __float_as_uint(f); u += 0x7FFFu + ((u >> 16) & 1u); return (bf16_t)(u >> 16); }
__device__ __forceinline__ float wave_sum(float v) {
#pragma unroll
    for (int o = 1; o < 64; o <<= 1) v += __shfl_xor(v, o);
    return v;
}
__device__ __forceinline__ float sigmoidf_(float x) { return 1.0f / (1.0f + __expf(-x)); }
#define GRID_SYNC() do { asm volatile("s_waitcnt vmcnt(0) lgkmcnt(0)" ::: "memory"); grid.sync(); } while (0)
__device__ __forceinline__ void grid_barrier(unsigned* ctr, unsigned target, int tid) {
    asm volatile("s_waitcnt vmcnt(0) lgkmcnt(0)" ::: "memory");
    __syncthreads();
    if (tid == 0) {
        __builtin_amdgcn_fence(__ATOMIC_RELEASE, "agent");
        __hip_atomic_fetch_add(ctr, 1u, __ATOMIC_RELAXED, __HIP_MEMORY_SCOPE_AGENT);
        while (__hip_atomic_load(ctr, __ATOMIC_RELAXED, __HIP_MEMORY_SCOPE_AGENT) < target) __builtin_amdgcn_s_sleep(1);
        __builtin_amdgcn_fence(__ATOMIC_ACQUIRE, "agent");
    }
    __syncthreads();
}
__device__ __forceinline__ int lane_id_opaque() { int l; asm volatile("v_mbcnt_lo_u32_b32 %0, -1, 0\n\tv_mbcnt_hi_u32_b32 %0, -1, %0" : "=v"(l)); return l; }
#define LDS_WAIT() asm volatile("s_waitcnt lgkmcnt(0)" ::: "memory")
#define MFMA16(a, b, c) __builtin_amdgcn_mfma_f32_16x16x32_bf16((a), (b), (c), 0, 0, 0)

__device__ __forceinline__ void tr_item(const float* W, int ldw, int K, bf16_t* WT, int drow0, int scol0, int nvalid, const float* scale, int smask, int k0, LAS float* scr, int lane) {
    const int n = lane & 31;
#pragma unroll 8
    for (int i = 0; i < 32; ++i) {
        const int kk = 2 * i + (lane >> 5); float v = 0.f;
        if (n < nvalid) { v = W[(size_t)(k0 + kk) * ldw + scol0 + n]; if (scale) v *= scale[(k0 + kk) & smask]; }
        scr[kk * 33 + n] = v;
    }
    LDS_WAIT(); asm volatile("" ::: "memory");
    const int c = lane & 7;
#pragma unroll
    for (int j = 0; j < 4; ++j) {
        const int nn = (lane >> 3) + 8 * j; const LAS float* s = scr + (8 * c) * 33 + nn;
        u32x4 o; o.x = pk2(s[0 * 33], s[1 * 33]); o.y = pk2(s[2 * 33], s[3 * 33]); o.z = pk2(s[4 * 33], s[5 * 33]); o.w = pk2(s[6 * 33], s[7 * 33]);
        *(u32x4*)(WT + (size_t)(drow0 + nn) * K + k0 + 8 * c) = o;
    }
    LDS_WAIT(); asm volatile("" ::: "memory");
}

__device__ __forceinline__ void p0_prologue(const Params& P, LAS unsigned char* lds, int tid, int lane, int wave) {
    unsigned char* ws = P.ws;
    const int G = gridDim.x, bid = blockIdx.x;
    if (bid == 0 && tid == 0) *(unsigned*)(ws + WS_BAR) = 0u;
    { const int gt = bid * 512 + tid; if (gt < T) { ((float*)(ws + WS_SSQ2))[gt] = 0.f; ((float*)(ws + WS_SSQ3))[gt] = 0.f; } }
    for (int it = bid; it < 64; it += G) {
        const int g = it >> 4, n0 = (it & 15) * 64;
        LAS float* LW = (LAS float*)lds;
        LAS float* LP = (LAS float*)(lds + 66560);
        __syncthreads();
        for (int i = 0; i < 32; ++i) { const int idx = tid + 512 * i; LW[(idx >> 7) * 129 + (idx & 127)] = P.w_pool_grp[(size_t)g * 16384 + idx]; }
        for (int i = 0; i < 16; ++i) { const int idx = tid + 512 * i; const int d = idx >> 6, nn = idx & 63; LP[idx] = P.w_pool_proj[(size_t)(g * 128 + d) * 1024 + n0 + nn] * P.pool_scale[g * 128 + d]; }
        __syncthreads();
        const int c = tid & 127, nq = tid >> 7;
        float acc[16];
#pragma unroll
        for (int j = 0; j < 16; ++j) acc[j] = 0.f;
        for (int d = 0; d < 128; ++d) {
            const float w = LW[c * 129 + d]; const LAS f32x4* pr = (const LAS f32x4*)(LP + d * 64 + nq * 16);
#pragma unroll
            for (int j4 = 0; j4 < 4; ++j4) { const f32x4 pv = pr[j4]; acc[4 * j4 + 0] += w * pv.x; acc[4 * j4 + 1] += w * pv.y; acc[4 * j4 + 2] += w * pv.z; acc[4 * j4 + 3] += w * pv.w; }
        }
        bf16_t* WeffT = (bf16_t*)(ws + WS_WEFF);
#pragma unroll
        for (int j = 0; j < 16; ++j) WeffT[(size_t)(n0 + nq * 16 + j) * 512 + g * 128 + c] = f2bf(acc[j]);
    }
    __syncthreads();
    LAS float* scr = (LAS float*)(lds + wave * 16384);
    const int gw = bid * 8 + wave, NGW = G * 8;
    for (int it = gw; it < 8192; it += NGW) {
        int r = it;
        if (r < 2944) { const int kb = r / 184, nb = r % 184, drow0 = nb * 32; int scol0, nvalid = 32;
            if (drow0 < 3584) scol0 = drow0; else if (drow0 < 5632) scol0 = drow0 + 16; else if (drow0 == 5632) { scol0 = 3584; nvalid = 16; } else { scol0 = 0; nvalid = 0; }
            tr_item(P.w_in, 5648, 1024, (bf16_t*)(ws + WS_WIN), drow0, scol0, nvalid, P.g_mix, 1023, kb * 64, scr, lane); continue; }
        r -= 2944;
        if (r < 2816) { const int kb = r / 176, nb = r % 176, drow0 = nb * 32; const int pn = drow0 >> 8, bj = (drow0 >> 7) & 1, c0 = drow0 & 127;
            tr_item(P.w_up, 5632, 1024, (bf16_t*)(ws + WS_WUP), drow0, bj * 2816 + 128 * pn + c0, 32, P.g_ffn, 1023, kb * 64, scr, lane); continue; }
        r -= 2816;
        if (r < 1408) { const int kb = r / 32, nb = r % 32; tr_item(P.w_down, 1024, 2816, (bf16_t*)(ws + WS_WDOWN), nb * 32, nb * 32, 32, nullptr, 0, kb * 64, scr, lane); continue; }
        r -= 1408;
        if (r < 512) { const int kb = r / 32, nb = r % 32; tr_item(P.w_gla_proj, 1024, 1024, (bf16_t*)(ws + WS_WGP), nb * 32, nb * 32, 32, P.g_gla_head, 255, kb * 64, scr, lane); continue; }
        r -= 512;
        { const int kb = r / 32, nb = r % 32; tr_item(P.w_out, 1024, 1024, (bf16_t*)(ws + WS_WOUT), nb * 32, nb * 32, 32, nullptr, 0, kb * 64, scr, lane); }
    }
    bf16_t* xb = (bf16_t*)(ws + WS_XB); float* rstd1 = (float*)(ws + WS_RSTD1);
    for (int m = gw; m < T; m += NGW) {
        const f32x4* xr = (const f32x4*)(P.x + (size_t)m * D) + lane;
        f32x4 v[4]; float s = 0.f;
#pragma unroll
        for (int j = 0; j < 4; ++j) { v[j] = xr[64 * j]; s += (v[j].x * v[j].x + v[j].y * v[j].y) + (v[j].z * v[j].z + v[j].w * v[j].w); }
        s = wave_sum(s);
        u32x2* o8 = (u32x2*)(xb + (size_t)m * D) + lane;
#pragma unroll
        for (int j = 0; j < 4; ++j) { u32x2 o; o.x = pk2(v[j].x, v[j].y); o.y = pk2(v[j].z, v[j].w); o8[64 * j] = o; }
        if (lane == 0) rstd1[m] = rsqrtf(s * (1.0f / D) + EPS);
    }
}

struct EpiIn {
    static constexpr bool PERM = true, AFTER_DRAIN = false;
    unsigned char* ws; const float* bgate;
    __device__ __forceinline__ void operator()(const f32x4 (&acc)[2][2][4][2], const pg8::Unit& u, int wr, int wc, int fr, int fq) const {
        const int pn = u.pn; const float* rstd = (const float*)(ws + WS_RSTD1);
        const int row0 = u.pm * 256 + wr * 64 + fr;
        if (pn == 22) {
            float* zgk = (float*)(ws + WS_ZGK);
#pragma unroll
            for (int ai = 0; ai < 2; ++ai)
#pragma unroll
                for (int m = 0; m < 4; ++m) { const int row = row0 + ai * 128 + m * 16; const float rs = rstd[row];
                    if (wc == 0 && fq < 2) { *(f32x4*)(zgk + (size_t)row * 16 + 8 * fq) = acc[ai][0][m][0] * rs; *(f32x4*)(zgk + (size_t)row * 16 + 8 * fq + 4) = acc[ai][0][m][1] * rs; } }
            return;
        }
        bf16_t* base; int ldc, colt, mode = 0; float mul = 1.f;
        if (pn < 2) { base = (bf16_t*)(ws + WS_ZPOOL); ldc = 512; colt = pn * 256; }
        else if (pn < 4) { base = (bf16_t*)(ws + WS_Q); ldc = 512; colt = (pn - 2) * 256; mul = 0.08838834764831845f; }
        else if (pn < 6) { base = (bf16_t*)(ws + WS_K); ldc = 512; colt = (pn - 4) * 256; }
        else if (pn < 10) { base = (bf16_t*)(ws + WS_V); ldc = 1024; colt = (pn - 6) * 256; }
        else if (pn < 14) { base = (bf16_t*)(ws + WS_OG); ldc = 1024; colt = (pn - 10) * 256; mode = 1; }
        else { base = (bf16_t*)(ws + WS_GATES); ldc = 2048; colt = (pn - 14) * 256; mode = 2; }
        const int col0 = colt + wc * 32 + 8 * fq;
        f32x4 bv[2][2];
#pragma unroll
        for (int bj = 0; bj < 2; ++bj)
#pragma unroll
            for (int n = 0; n < 2; ++n) bv[bj][n] = (mode == 2) ? *(const f32x4*)(bgate + col0 + bj * 128 + 4 * n) : (f32x4){0.f, 0.f, 0.f, 0.f};
#pragma unroll
        for (int ai = 0; ai < 2; ++ai)
#pragma unroll
            for (int m = 0; m < 4; ++m) { const int row = row0 + ai * 128 + m * 16; const float rs = rstd[row] * mul; bf16_t* rowp = base + (size_t)row * ldc + col0;
#pragma unroll
                for (int bj = 0; bj < 2; ++bj) { f32x4 v0 = acc[ai][bj][m][0] * rs + bv[bj][0], v1 = acc[ai][bj][m][1] * rs + bv[bj][1];
                    if (mode == 1) {
#pragma unroll
                        for (int j = 0; j < 4; ++j) { v0[j] = v0[j] * sigmoidf_(v0[j]); v1[j] = v1[j] * sigmoidf_(v1[j]); } }
                    else if (mode == 2) {
#pragma unroll
                        for (int j = 0; j < 4; ++j) { v0[j] = sigmoidf_(v0[j]); v1[j] = sigmoidf_(v1[j]); } }
                    u32x4 w; w.x = pk2(v0[0], v0[1]); w.y = pk2(v0[2], v0[3]); w.z = pk2(v1[0], v1[1]); w.w = pk2(v1[2], v1[3]);
                    *(u32x4*)(rowp + bj * 128) = w; } }
    }
};
template <int MODE> struct EpiGate {
    static constexpr bool PERM = true, AFTER_DRAIN = false;
    const bf16_t* gates; int gcol0; const bf16_t* prev; bf16_t* out;
    __device__ __forceinline__ void operator()(const f32x4 (&acc)[2][2][4][2], const pg8::Unit& u, int wr, int wc, int fr, int fq) const {
        const int row0 = u.pm * 256 + wr * 64 + fr, col0 = u.pn * 256 + wc * 32 + 8 * fq;
#pragma unroll
        for (int ai = 0; ai < 2; ++ai)
#pragma unroll
            for (int m = 0; m < 4; ++m) { const int row = row0 + ai * 128 + m * 16;
#pragma unroll
                for (int bj = 0; bj < 2; ++bj) { const int col = col0 + bj * 128;
                    const u32x4 gv = *(const u32x4*)(gates + (size_t)row * 2048 + gcol0 + col);
                    float o[8];
                    o[0] = bflo(gv.x) * acc[ai][bj][m][0][0]; o[1] = bfhi(gv.x) * acc[ai][bj][m][0][1]; o[2] = bflo(gv.y) * acc[ai][bj][m][0][2]; o[3] = bfhi(gv.y) * acc[ai][bj][m][0][3];
                    o[4] = bflo(gv.z) * acc[ai][bj][m][1][0]; o[5] = bfhi(gv.z) * acc[ai][bj][m][1][1]; o[6] = bflo(gv.w) * acc[ai][bj][m][1][2]; o[7] = bfhi(gv.w) * acc[ai][bj][m][1][3];
                    if (MODE == 1) { const u32x4 pv = *(const u32x4*)(prev + (size_t)row * 1024 + col);
                        o[0] += bflo(pv.x); o[1] += bfhi(pv.x); o[2] += bflo(pv.y); o[3] += bfhi(pv.y); o[4] += bflo(pv.z); o[5] += bfhi(pv.z); o[6] += bflo(pv.w); o[7] += bfhi(pv.w); }
                    u32x4 w; w.x = pk2(o[0], o[1]); w.y = pk2(o[2], o[3]); w.z = pk2(o[4], o[5]); w.w = pk2(o[6], o[7]);
                    *(u32x4*)(out + (size_t)row * 1024 + col) = w; }
                asm volatile("" ::: "memory"); }
    }
};
template <bool WRITE_BF> struct EpiRes {
    static constexpr bool PERM = false, AFTER_DRAIN = false;
    const float* base; float* xo; bf16_t* xbo; float* ssq;
    __device__ __forceinline__ void operator()(const f32x4 (&acc)[2][2][4][2], const pg8::Unit& u, int wr, int wc, int fr, int fq) const {
        const int row0 = u.pm * 256 + wr * 64 + fr, col0 = u.pn * 256 + wc * 32 + 4 * fq;
#pragma unroll
        for (int ai = 0; ai < 2; ++ai)
#pragma unroll
            for (int m = 0; m < 4; ++m) { const int row = row0 + ai * 128 + m * 16; const size_t off = (size_t)row * 1024 + col0; float s = 0.f;
#pragma unroll
                for (int bj = 0; bj < 2; ++bj)
#pragma unroll
                    for (int n = 0; n < 2; ++n) { const size_t o = off + bj * 128 + n * 16; const f32x4 v = *(const f32x4*)(base + o) + acc[ai][bj][m][n];
                        *(f32x4*)(xo + o) = v; s += (v.x * v.x + v.y * v.y) + (v.z * v.z + v.w * v.w);
                        if (WRITE_BF) { u32x2 w; w.x = pk2(v.x, v.y); w.y = pk2(v.z, v.w); *(u32x2*)(xbo + o) = w; } }
                s += __shfl_xor(s, 16); s += __shfl_xor(s, 32);
                if (fq == 0) atomicAdd(ssq + row, s);
                asm volatile("" ::: "memory"); }
    }
};
__device__ __forceinline__ float dpp_shr1(float old, float src) { return __builtin_bit_cast(float, __builtin_amdgcn_update_dpp(__builtin_bit_cast(int, old), __builtin_bit_cast(int, src), 0x111, 0xf, 0xf, false)); }
__device__ __forceinline__ float dpp_shr2(float old, float src) { return __builtin_bit_cast(float, __builtin_amdgcn_update_dpp(__builtin_bit_cast(int, old), __builtin_bit_cast(int, src), 0x112, 0xf, 0xf, false)); }
__device__ __forceinline__ float dpp_ror1(float src) { return __builtin_bit_cast(float, __builtin_amdgcn_update_dpp(0, __builtin_bit_cast(int, src), 0x121, 0xf, 0xf, false)); }
__device__ __forceinline__ float dpp_ror2(float src) { return __builtin_bit_cast(float, __builtin_amdgcn_update_dpp(0, __builtin_bit_cast(int, src), 0x122, 0xf, 0xf, false)); }
struct EpiUpConv {
    static constexpr bool PERM = true, AFTER_DRAIN = false;
    const float* ssq; const float* wconv; const float* bconv; bf16_t* aout; float* hbuf; float* pbuf;
    __device__ __forceinline__ void operator()(const f32x4 (&acc)[2][2][4][2], const pg8::Unit& u, int wr, int wc, int fr, int fq) const {
        typedef float f32x2 __attribute__((ext_vector_type(2)));
        {
            const int ln = lane_id_opaque(); fr = ln & 15; fq = ln >> 4; }
        const unsigned c0 = 128u * u.pn + 32u * wc + 8u * fq, row0 = u.pm * 256u + wr * 64u + fr;
#pragma unroll
        for (int ai = 0; ai < 2; ++ai) {
            const unsigned B = 4u * u.pm + 2u * ai + wr; const bool part = ((B & 31u) != 0u) && fr < 2, halo = fr >= 14;
            const unsigned pbo = ((B * 2u + fr) * 2u) * 2816u + c0, hbo = ((B * 2u + ((unsigned)fr & 1u)) * 2u) * 2816u + c0, aoff = (row0 + (unsigned)(ai * 128)) * (unsigned)DFF + c0;
#pragma unroll
            for (int n = 0; n < 2; ++n) {
                unsigned keep[4];
#pragma unroll
                for (int jh = 0; jh < 2; ++jh) {
                    const unsigned cl = 4u * n + 2u * jh, c = c0 + cl;
                    const unsigned cb = c * 4u;
#define LDW(base, boff) (*(const f32x2*)((const char*)(base) + (boff)))
                    const f32x2 gw0 = LDW(wconv, cb), gw1 = LDW(wconv, cb + 22528u), gw2 = LDW(wconv, cb + 45056u), gb = LDW(bconv, cb);
                    const f32x2 vw0 = LDW(wconv, cb + 11264u), vw1 = LDW(wconv, cb + 33792u), vw2 = LDW(wconv, cb + 56320u), vb = LDW(bconv, cb + 11264u);
#undef LDW
                    f32x2 pg = (f32x2){0.f, 0.f}, pv = (f32x2){0.f, 0.f};
#pragma unroll
                    for (int m = 0; m < 4; ++m) {
                        const float rsm = rsqrtf(*(const float*)((const char*)ssq + (row0 * 4u + (unsigned)((ai * 128 + m * 16) * 4))) * (1.0f / D) + EPS);
                        const f32x2 ug = (f32x2){acc[ai][0][m][n][2 * jh], acc[ai][0][m][n][2 * jh + 1]} * rsm, uv = (f32x2){acc[ai][1][m][n][2 * jh], acc[ai][1][m][n][2 * jh + 1]} * rsm;
                        f32x2 g1, g2, v1, v2;
#pragma unroll
                        for (int j = 0; j < 2; ++j) {
                            g1[j] = dpp_shr1(m ? dpp_ror1(pg[j]) : 0.f, ug[j]); g2[j] = dpp_shr2(m ? dpp_ror2(pg[j]) : 0.f, ug[j]);
                            v1[j] = dpp_shr1(m ? dpp_ror1(pv[j]) : 0.f, uv[j]); v2[j] = dpp_shr2(m ? dpp_ror2(pv[j]) : 0.f, uv[j]);
                        }
                        const f32x2 cg = gb + gw0 * g2 + gw1 * g1 + gw2 * ug, cv = vb + vw0 * v2 + vw1 * v1 + vw2 * uv;
                        if (m == 0) { if (part) { *(f32x2*)((char*)pbuf + (pbo * 4u + cl * 4u)) = cg; *(f32x2*)((char*)pbuf + (pbo * 4u + 11264u + cl * 4u)) = cv; } }
                        if (m == 3) { if (halo) { *(f32x2*)((char*)hbuf + (hbo * 4u + cl * 4u)) = ug; *(f32x2*)((char*)hbuf + (hbo * 4u + 11264u + cl * 4u)) = uv; } }
                        const unsigned pkd = pk2(cg[0] * sigmoidf_(cg[0]) * cv[0], cg[1] * sigmoidf_(cg[1]) * cv[1]);
                        if (jh == 0) keep[m] = pkd;
                        else { u32x2 w; w.x = keep[m]; w.y = pkd; *(u32x2*)((char*)aout + (aoff * 2u + (unsigned)(m * 16 * DFF * 2) + 8u * n)) = w; }
                        pg = ug; pv = uv;
                    }
                    asm volatile("" ::: "memory");
                }
            }
        }
    }
};

template <int MODE>
__device__ __forceinline__ void gla_unit(LAS unsigned char* lds, int uid, const Params& P, int tid, int lane, int wave) {
    unsigned char* ws = P.ws;
    const float* zgk = (const float*)(ws + WS_ZGK);
    const bf16_t* q = (const bf16_t*)(ws + WS_Q); const bf16_t* k = (const bf16_t*)(ws + WS_K); bf16_t* v = (bf16_t*)(ws + WS_V);
    bf16_t* kvT = (bf16_t*)P.out; float* dvec = (float*)(ws + WS_DVEC); const bf16_t* ogs = (const bf16_t*)(ws + WS_OG);
    const int h = uid & 3, n = (uid >> 2) & 31, b = uid >> 7, t0 = b * 2048 + n * 64;
    const int kk = tid & 127, sg = tid >> 7, l15 = lane & 15, quad = lane >> 4;
    LAS float* Lz = (LAS float*)(lds + L_ZGK); LAS float* Ltot = (LAS float*)(lds + L_TOT);
    bf16_t* stbase = kvT + (size_t)((b * 4 + h) * 32 + n) * 32768;
    __syncthreads();
    if (tid < 256) ((LAS f32x4*)Lz)[tid] = ((const f32x4*)(zgk + (size_t)t0 * 16))[tid];
    {
        const int vcol = tid & 255, sh = tid >> 8; const bf16_t* vp = v + (size_t)(t0 + sh * 32) * 1024 + h * 256 + vcol;
        unsigned pk[16];
#pragma unroll
        for (int i = 0; i < 16; ++i) { const unsigned lo = vp[(size_t)(2 * i) * 1024], hi = vp[(size_t)(2 * i + 1) * 1024]; pk[i] = lo | (hi << 16); }
        LAS u32x4* d = (LAS u32x4*)(lds + L_VT + vcol * 144 + sh * 64);
#pragma unroll
        for (int j = 0; j < 4; ++j) d[j] = (u32x4){pk[4 * j], pk[4 * j + 1], pk[4 * j + 2], pk[4 * j + 3]};
    }
    float la[16];
    {
        float w[16];
#pragma unroll
        for (int r = 0; r < 16; ++r) w[r] = P.w_gk_up[r * 512 + h * 128 + kk];
        const float bb = P.b_gk[h * 128 + kk];
        __syncthreads();
#pragma unroll
        for (int i = 0; i < 16; ++i) {
            const LAS f32x4* zr = (const LAS f32x4*)(Lz + (sg * 16 + i) * 16); const f32x4 z0 = zr[0], z1 = zr[1], z2 = zr[2], z3 = zr[3];
            float xg = bb;
            xg += z0.x * w[0]; xg += z0.y * w[1]; xg += z0.z * w[2]; xg += z0.w * w[3]; xg += z1.x * w[4]; xg += z1.y * w[5]; xg += z1.z * w[6]; xg += z1.w * w[7];
            xg += z2.x * w[8]; xg += z2.y * w[9]; xg += z2.z * w[10]; xg += z2.w * w[11]; xg += z3.x * w[12]; xg += z3.y * w[13]; xg += z3.z * w[14]; xg += z3.w * w[15];
            const float ls = fminf(xg, 0.f) - __logf(1.0f + __expf(-fabsf(xg)));
            la[i] = ls * 0.0625f;
        }
    }
#pragma unroll
    for (int i = 1; i < 16; ++i) la[i] += la[i - 1];
    Ltot[sg * 128 + kk] = la[15];
    __syncthreads();
    const float ts0 = Ltot[kk], ts1 = Ltot[128 + kk], ts2 = Ltot[256 + kk], ts3 = Ltot[384 + kk];
    const float off = (sg > 0 ? ts0 : 0.f) + (sg > 1 ? ts1 : 0.f) + (sg > 2 ? ts2 : 0.f), blast = (ts0 + ts1) + (ts2 + ts3);
    if (MODE == 0) {
        const bf16_t* kp = k + (size_t)(t0 + sg * 16) * 512 + h * 128 + kk;
        unsigned pk[8];
#pragma unroll
        for (int i = 0; i < 8; ++i) {
            const float k0 = bf2f(kp[(size_t)(2 * i) * 512]) * __expf(blast - (la[2 * i] + off)), k1 = bf2f(kp[(size_t)(2 * i + 1) * 512]) * __expf(blast - (la[2 * i + 1] + off));
            pk[i] = pk2(k0, k1);
        }
        LAS u32x4* d = (LAS u32x4*)(lds + L_KD + kk * 144 + sg * 32);
        d[0] = (u32x4){pk[0], pk[1], pk[2], pk[3]}; d[1] = (u32x4){pk[4], pk[5], pk[6], pk[7]};
        if (sg == 0) dvec[(size_t)uid * 128 + kk] = __expf(blast);
        __syncthreads();
        f32x4 acc[2][8];
#pragma unroll
        for (int mt = 0; mt < 2; ++mt)
#pragma unroll
            for (int nt = 0; nt < 8; ++nt) acc[mt][nt] = (f32x4){0.f, 0.f, 0.f, 0.f};
#pragma unroll
        for (int ks = 0; ks < 2; ++ks) {
            bf16x8 bv[2];
#pragma unroll
            for (int mt = 0; mt < 2; ++mt) bv[mt] = *(const LAS bf16x8*)(lds + L_VT + ((2 * wave + mt) * 16 + l15) * 144 + ks * 64 + quad * 16);
#pragma unroll
            for (int nt = 0; nt < 8; ++nt) {
                const bf16x8 a = *(const LAS bf16x8*)(lds + L_KD + (nt * 16 + l15) * 144 + ks * 64 + quad * 16);
#pragma unroll
                for (int mt = 0; mt < 2; ++mt) acc[mt][nt] = MFMA16(a, bv[mt], acc[mt][nt]);
            }
        }
#pragma unroll
        for (int mt = 0; mt < 2; ++mt)
#pragma unroll
            for (int nt = 0; nt < 8; ++nt) { u32x2 o; o.x = pk2(acc[mt][nt][0], acc[mt][nt][1]); o.y = pk2(acc[mt][nt][2], acc[mt][nt][3]);
                *(u32x2*)(stbase + ((2 * wave + mt) * 16 + l15) * 128 + nt * 16 + quad * 4) = o; }
    } else {
        const bf16_t* qp = q + (size_t)(t0 + sg * 16) * 512 + h * 128 + kk; const bf16_t* kp = k + (size_t)(t0 + sg * 16) * 512 + h * 128 + kk;
        LAS bf16_t* QF = (LAS bf16_t*)(lds + L_QF); LAS bf16_t* QB = (LAS bf16_t*)(lds + L_QB); LAS bf16_t* KF = (LAS bf16_t*)(lds + L_KF); LAS bf16_t* KB = (LAS bf16_t*)(lds + L_KB);
#pragma unroll
        for (int i = 0; i < 16; ++i) {
            const int s = sg * 16 + i; const float bc = la[i] + off, ep = __expf(bc), en = __expf(-bc);
            const float qv = bf2f(qp[(size_t)i * 512]), kv = bf2f(kp[(size_t)i * 512]);
            QF[s * 136 + kk] = f2bf(qv * ep); QB[s * 136 + kk] = f2bf(qv * en); KF[s * 136 + kk] = f2bf(kv * en); KB[s * 136 + kk] = f2bf(kv * ep);
        }
        bf16x8 stf[2][4];
#pragma unroll
        for (int vt = 0; vt < 2; ++vt)
#pragma unroll
            for (int ks = 0; ks < 4; ++ks) stf[vt][ks] = *(const bf16x8*)(stbase + ((2 * wave + vt) * 16 + l15) * 128 + ks * 32 + quad * 8);
        __syncthreads();
        {
            const int tt = wave >> 1;
#pragma unroll
            for (int sti = 0; sti < 2; ++sti) {
                const int st = (wave & 1) * 2 + sti; f32x4 fw = (f32x4){0.f, 0.f, 0.f, 0.f}, bw = (f32x4){0.f, 0.f, 0.f, 0.f};
#pragma unroll
                for (int ks = 0; ks < 4; ++ks) {
                    const int oa = (st * 16 + l15) * 272 + ks * 64 + quad * 16, ob_ = (tt * 16 + l15) * 272 + ks * 64 + quad * 16;
                    fw = MFMA16(*(const LAS bf16x8*)(lds + L_KF + oa), *(const LAS bf16x8*)(lds + L_QF + ob_), fw);
                    bw = MFMA16(*(const LAS bf16x8*)(lds + L_KB + oa), *(const LAS bf16x8*)(lds + L_QB + ob_), bw);
                }
                const int t = tt * 16 + l15, s0 = st * 16 + quad * 4;
                float p[4];
#pragma unroll
                for (int r = 0; r < 4; ++r) p[r] = (s0 + r <= t) ? fw[r] : bw[r];
                u32x2 o; o.x = pk2(p[0], p[1]); o.y = pk2(p[2], p[3]);
                *(LAS u32x2*)(lds + L_P + t * 144 + s0 * 2) = o;
            }
        }
        __syncthreads();
        f32x4 acc[2][4];
#pragma unroll
        for (int vt = 0; vt < 2; ++vt)
#pragma unroll
            for (int tt = 0; tt < 4; ++tt) acc[vt][tt] = (f32x4){0.f, 0.f, 0.f, 0.f};
#pragma unroll
        for (int ks = 0; ks < 2; ++ks) {
            bf16x8 av[2];
#pragma unroll
            for (int vt = 0; vt < 2; ++vt) av[vt] = *(const LAS bf16x8*)(lds + L_VT + ((2 * wave + vt) * 16 + l15) * 144 + ks * 64 + quad * 16);
#pragma unroll
            for (int tt = 0; tt < 4; ++tt) { const bf16x8 bp = *(const LAS bf16x8*)(lds + L_P + (tt * 16 + l15) * 144 + ks * 64 + quad * 16);
#pragma unroll
                for (int vt = 0; vt < 2; ++vt) acc[vt][tt] = MFMA16(av[vt], bp, acc[vt][tt]); }
        }
#pragma unroll
        for (int ks = 0; ks < 4; ++ks)
#pragma unroll
            for (int tt = 0; tt < 4; ++tt) { const bf16x8 bq = *(const LAS bf16x8*)(lds + L_QF + (tt * 16 + l15) * 272 + ks * 64 + quad * 16);
#pragma unroll
                for (int vt = 0; vt < 2; ++vt) acc[vt][tt] = MFMA16(stf[vt][ks], bq, acc[vt][tt]); }
        LAS float* Lred = (LAS float*)(lds + L_RED);
#pragma unroll
        for (int tt = 0; tt < 4; ++tt) {
            float s = 0.f;
#pragma unroll
            for (int vt = 0; vt < 2; ++vt) s += (acc[vt][tt][0] * acc[vt][tt][0] + acc[vt][tt][1] * acc[vt][tt][1]) + (acc[vt][tt][2] * acc[vt][tt][2] + acc[vt][tt][3] * acc[vt][tt][3]);
            s += __shfl_xor(s, 16); s += __shfl_xor(s, 32);
            if (quad == 0) Lred[wave * 64 + tt * 16 + l15] = s;
        }
        __syncthreads();
#pragma unroll
        for (int tt = 0; tt < 4; ++tt) {
            const int t = tt * 16 + l15; float tot = 0.f;
#pragma unroll
            for (int w8 = 0; w8 < 8; ++w8) tot += Lred[w8 * 64 + t];
            const float rs = rsqrtf(tot * (1.0f / 256.0f) + EPS);
#pragma unroll
            for (int vt = 0; vt < 2; ++vt) {
                const size_t o = (size_t)(t0 + t) * 1024 + h * 256 + (2 * wave + vt) * 16 + quad * 4;
                const u32x2 gv = *(const u32x2*)(ogs + o);
                u32x2 w; w.x = pk2(acc[vt][tt][0] * rs * bflo(gv.x), acc[vt][tt][1] * rs * bfhi(gv.x)); w.y = pk2(acc[vt][tt][2] * rs * bflo(gv.y), acc[vt][tt][3] * rs * bfhi(gv.y));
                *(u32x2*)(v + o) = w;
            }
        }
    }
}

__device__ __forceinline__ int mk_tid(int wave0) { return wave0 * 64 + lane_id_opaque(); }
__global__ void __launch_bounds__(512, 2) fwd_megakernel(Params P) {
    extern __shared__ __attribute__((aligned(16))) unsigned char lds_raw[];
    LAS unsigned char* lds = (LAS unsigned char*)lds_raw;
    cg::grid_group grid = cg::this_grid();
    const int G = gridDim.x, bid = blockIdx.x;
    const int wave0 = __builtin_amdgcn_readfirstlane(threadIdx.x >> 6);
    const size_t gsz = (size_t)G * 512;
    unsigned char* ws = P.ws;
#define PHASE_TID() int tid = mk_tid(wave0); asm volatile("" : "+v"(tid)); const int lane = tid & 63, wave = __builtin_amdgcn_readfirstlane(tid >> 6); const size_t gtid = (size_t)bid * 512 + tid; (void)lane; (void)wave; (void)gtid

#define IN(k) (P.ph_lo <= (k) && (k) < P.ph_hi)
    unsigned nbar = 0;
#define SEAM(k) do { if (IN(k) && IN((k) + 1)) { if ((k) == 0) GRID_SYNC(); else { ++nbar; grid_barrier((unsigned*)(ws + WS_BAR), nbar * (unsigned)G, mk_tid(wave0)); } } } while (0)
    if (IN(0)) { PHASE_TID(); p0_prologue(P, lds, tid, lane, wave); }
    SEAM(0);

    if (IN(1)) { pg8::Gemm g{(const bf16_t*)(ws + WS_XB), (const bf16_t*)(ws + WS_WIN), T, NIN, D}; pg8::StaticOrder S; S.init(T, NIN, G, bid);
      EpiIn E{ws, P.b_gate}; pg8::gemm_phase<EpiIn, pg8::StaticOrder, false>(lds, g, S, E, nullptr, mk_tid(wave0)); }
    SEAM(1);

    if (IN(2)) {
        PHASE_TID();
        const unsigned* zp = (const unsigned*)(ws + WS_ZPOOL); unsigned* pp = (unsigned*)(ws + WS_XB);
        for (size_t idx = gtid; idx < (size_t)512 * 256; idx += gsz) {
            const int cp = (int)(idx & 255), tb = (int)(idx >> 8), t0 = tb * 32, pos0 = t0 & 2047, w = 2 << (cp >> 6);
            float s0 = 0.f, s1 = 0.f;
            for (int i = 1; i < w; ++i) if (pos0 - i >= 0) { const unsigned uu = zp[(size_t)(t0 - i) * 256 + cp]; s0 += bflo(uu); s1 += bfhi(uu); }
            for (int tt = 0; tt < 32; ++tt) {
                const int t = t0 + tt, pos = pos0 + tt; const unsigned uu = zp[(size_t)t * 256 + cp]; const float a0 = bflo(uu), a1 = bfhi(uu);
                s0 += a0; s1 += a1;
                const float inv = 1.0f / (float)min(pos + 1, w);
                pp[(size_t)t * 256 + cp] = pk2(s0 * inv - a0, s1 * inv - a1);
                if (pos - (w - 1) >= 0) { const unsigned uo = zp[(size_t)(t - (w - 1)) * 256 + cp]; s0 -= bflo(uo); s1 -= bfhi(uo); }
            }
        }
        for (int uid = bid; uid < 1024; uid += G) gla_unit<0>(lds, uid, P, tid, lane, wave);
    }
    SEAM(2);

    if (IN(3)) {
        PHASE_TID();
        bf16_t* kvT = (bf16_t*)P.out; const float* dvec = (const float*)(ws + WS_DVEC);
        for (size_t e = gtid; e < 131072; e += gsz) {
            const int bh = (int)(e >> 12), vec = (int)(e & 4095), b = bh >> 2, h = bh & 3, kk0 = (vec * 8) & 127;
            float S[8];
#pragma unroll
            for (int j = 0; j < 8; ++j) S[j] = 0.f;
#pragma unroll 4
            for (int n = 0; n < 32; ++n) {
                u32x4* ptr = (u32x4*)(kvT + (size_t)(bh * 32 + n) * 32768 + (size_t)vec * 8);
                const float* dp = dvec + (size_t)(b * 128 + n * 4 + h) * 128 + kk0;
                const u32x4 kv = *ptr; const f32x4 d0 = *(const f32x4*)dp, d1 = *(const f32x4*)(dp + 4);
                u32x4 o; o.x = pk2(S[0], S[1]); o.y = pk2(S[2], S[3]); o.z = pk2(S[4], S[5]); o.w = pk2(S[6], S[7]);
                *ptr = o;
                S[0] = d0.x * S[0] + bflo(kv.x); S[1] = d0.y * S[1] + bfhi(kv.x); S[2] = d0.z * S[2] + bflo(kv.y); S[3] = d0.w * S[3] + bfhi(kv.y);
                S[4] = d1.x * S[4] + bflo(kv.z); S[5] = d1.y * S[5] + bfhi(kv.z); S[6] = d1.z * S[6] + bflo(kv.w); S[7] = d1.w * S[7] + bfhi(kv.w);
            }
        }
    }
    SEAM(3);

    if (IN(4)) { PHASE_TID(); for (int uid = bid; uid < 1024; uid += G) gla_unit<1>(lds, uid, P, tid, lane, wave); }
    SEAM(4);

    if (IN(5)) {
    { pg8::Gemm g{(const bf16_t*)(ws + WS_XB), (const bf16_t*)(ws + WS_WEFF), T, D, 512}; pg8::StaticOrder S; S.init(T, D, G, bid);
      EpiGate<0> E{(const bf16_t*)(ws + WS_GATES), 0, nullptr, (bf16_t*)(ws + WS_YPG)}; pg8::gemm_phase<EpiGate<0>, pg8::StaticOrder, false>(lds, g, S, E, nullptr, mk_tid(wave0)); }
    __syncthreads();
    { pg8::Gemm g{(const bf16_t*)(ws + WS_V), (const bf16_t*)(ws + WS_WGP), T, D, D}; pg8::StaticOrder S; S.init(T, D, G, bid);
      EpiGate<1> E{(const bf16_t*)(ws + WS_GATES), 1024, (const bf16_t*)(ws + WS_YPG), (bf16_t*)(ws + WS_MIXED)}; pg8::gemm_phase<EpiGate<1>, pg8::StaticOrder, false>(lds, g, S, E, nullptr, mk_tid(wave0)); }
    }
    SEAM(5);

    if (IN(6)) { pg8::Gemm g{(const bf16_t*)(ws + WS_MIXED), (const bf16_t*)(ws + WS_WOUT), T, D, D}; pg8::StaticOrder S; S.init(T, D, G, bid);
      EpiRes<true> E{P.x, P.out, (bf16_t*)(ws + WS_XB), (float*)(ws + WS_SSQ2)}; pg8::gemm_phase<EpiRes<true>, pg8::StaticOrder, false>(lds, g, S, E, nullptr, mk_tid(wave0)); }
    SEAM(6);

    if (IN(7)) { pg8::Gemm g{(const bf16_t*)(ws + WS_XB), (const bf16_t*)(ws + WS_WUP), T, 2 * DFF, D}; pg8::StaticOrder S; S.init(T, 2 * DFF, G, bid);
      EpiUpConv E{(const float*)(ws + WS_SSQ2), P.w_conv, P.b_conv, (bf16_t*)(ws + WS_A), (float*)(ws + WS_HBUF), (float*)(ws + WS_PBUF)}; pg8::gemm_phase<EpiUpConv, pg8::StaticOrder, false>(lds, g, S, E, nullptr, mk_tid(wave0)); }
    SEAM(7);

    if (IN(8)) {
        {
            PHASE_TID();
            pg8::StaticOrder S0; S0.init(T, D, G, bid); pg8::Unit u0;
            if (S0.next(0, u0)) {
                const float* hbuf = (const float*)(ws + WS_HBUF); const float* pbuf = (const float*)(ws + WS_PBUF); bf16_t* aout = (bf16_t*)(ws + WS_A);
                for (int idx = tid; idx < 4 * 2 * 704; idx += 512) {
                    const int bl = idx / 1408, rem = idx % 1408, rb = rem / 704, c = (rem % 704) * 4, B = 4 * u0.pm + bl;
                    if ((B & 31) == 0) continue;
                    const float* pb = pbuf + (size_t)((B * 2 + rb) * 2) * 2816 + c; const float* h0 = hbuf + (size_t)(((B - 1) * 2 + 0) * 2) * 2816 + c; const float* h1 = hbuf + (size_t)(((B - 1) * 2 + 1) * 2) * 2816 + c;
                    f32x4 cg = *(const f32x4*)pb, cv = *(const f32x4*)(pb + 2816);
                    const f32x4 h1g = *(const f32x4*)h1, h1v = *(const f32x4*)(h1 + 2816);
                    const f32x4 wg0 = *(const f32x4*)(P.w_conv + c), wv0 = *(const f32x4*)(P.w_conv + 2816 + c);
                    if (rb == 0) { const f32x4 h0g = *(const f32x4*)h0, h0v = *(const f32x4*)(h0 + 2816); const f32x4 wg1 = *(const f32x4*)(P.w_conv + 5632 + c), wv1 = *(const f32x4*)(P.w_conv + 5632 + 2816 + c);
                        cg += wg1 * h1g + wg0 * h0g; cv += wv1 * h1v + wv0 * h0v; }
                    else { cg += wg0 * h1g; cv += wv0 * h1v; }
                    u32x2 w; w.x = pk2(cg[0] * sigmoidf_(cg[0]) * cv[0], cg[1] * sigmoidf_(cg[1]) * cv[1]); w.y = pk2(cg[2] * sigmoidf_(cg[2]) * cv[2], cg[3] * sigmoidf_(cg[3]) * cv[3]);
                    *(u32x2*)(aout + (size_t)(B * 64 + rb) * DFF + c) = w;
                }
            }
            asm volatile("s_waitcnt vmcnt(0)" ::: "memory");
            __syncthreads();
        }
 pg8::Gemm g{(const bf16_t*)(ws + WS_A), (const bf16_t*)(ws + WS_WDOWN), T, D, DFF}; pg8::StaticOrder S; S.init(T, D, G, bid);
      EpiRes<false> E{P.out, P.out, nullptr, (float*)(ws + WS_SSQ3)}; pg8::gemm_phase<EpiRes<false>, pg8::StaticOrder, false>(lds, g, S, E, nullptr, mk_tid(wave0)); }
    SEAM(8);

    if (P.ph_lo == 101) { PHASE_TID();
        const bf16_t* zp = (const bf16_t*)(ws + WS_ZPOOL); const bf16_t* q = (const bf16_t*)(ws + WS_Q); const bf16_t* k = (const bf16_t*)(ws + WS_K); const bf16_t* v = (const bf16_t*)(ws + WS_V);
        const bf16_t* og = (const bf16_t*)(ws + WS_OG); const bf16_t* ga = (const bf16_t*)(ws + WS_GATES); const float* zgk = (const float*)(ws + WS_ZGK); const float* r1 = (const float*)(ws + WS_RSTD1);
        for (size_t i = gtid; i < (size_t)T * 1024; i += gsz) { const size_t t = i >> 10, c = i & 1023;
            P.out[i] = bf2f(zp[t * 512 + (c & 511)]) + bf2f(q[t * 512 + (c & 511)]) + bf2f(k[t * 512 + (c & 511)]) + bf2f(v[i]) + bf2f(og[i]) + bf2f(ga[t * 2048 + c]) + bf2f(ga[t * 2048 + 1024 + c]) + zgk[t * 16 + (c & 15)] + r1[t]; }
    }
    if (P.ph_lo == 102) { PHASE_TID();
        const bf16_t* xb = (const bf16_t*)(ws + WS_XB); const bf16_t* w1 = (const bf16_t*)(ws + WS_WIN); const bf16_t* w2 = (const bf16_t*)(ws + WS_WUP); const bf16_t* w3 = (const bf16_t*)(ws + WS_WDOWN);
        const bf16_t* w4 = (const bf16_t*)(ws + WS_WGP); const bf16_t* w5 = (const bf16_t*)(ws + WS_WOUT); const bf16_t* w6 = (const bf16_t*)(ws + WS_WEFF);
        for (size_t i = gtid; i < (size_t)T * 1024; i += gsz)
            P.out[i] = bf2f(xb[i]) + bf2f(w1[i % ((size_t)5888 * 1024)]) + bf2f(w2[i % ((size_t)5632 * 1024)]) + bf2f(w3[i % ((size_t)1024 * 2816)]) + bf2f(w4[i & 1048575]) + bf2f(w5[i & 1048575]) + bf2f(w6[i & 524287]);
    }
    if (P.ph_lo == 110) { PHASE_TID();
        const bf16_t* kv = (const bf16_t*)P.out; float* red = (float*)(ws + WS_XB + 16 * MiB); const float* dv = (const float*)(ws + WS_DVEC);
        for (size_t g = gtid; g < 131072; g += gsz) { float s = dv[g]; for (int j = 0; j < 256; ++j) s += bf2f(kv[g + (size_t)j * 131072]); red[g] = s; }
    }
    if (P.ph_lo == 111) { PHASE_TID();
        const float* red = (const float*)(ws + WS_XB + 16 * MiB); const bf16_t* pp = (const bf16_t*)(ws + WS_XB);
        for (size_t i = gtid; i < (size_t)T * 1024; i += gsz) { const size_t t = i >> 10, c = i & 1023; float vv = red[i & 131071] * (MK_DUMPSEL & 1 ? 1.f : 0.f) + bf2f(pp[t * 512 + (c & 511)]) * (MK_DUMPSEL & 2 ? 1.f : 0.f); if (!(fabsf(vv) < 1e30f)) vv = 777.f; P.out[i] = vv; }
    }
    if (P.ph_lo == 104) { PHASE_TID();
        const bf16_t* ob = (const bf16_t*)(ws + WS_V); const bf16_t* pp = (const bf16_t*)(ws + WS_XB);
        for (size_t i = gtid; i < (size_t)T * 1024; i += gsz) { const size_t t = i >> 10, c = i & 1023; P.out[i] = bf2f(ob[i]) + bf2f(pp[t * 512 + (c & 511)]); }
    }
    if (IN(9)) {
        PHASE_TID();
        const float* ssq3 = (const float*)(ws + WS_SSQ3); const int gw = bid * 8 + wave, NGW = G * 8;
        for (int m = gw; m < T; m += NGW) {
            const float rs = rsqrtf(ssq3[m] * (1.0f / D) + EPS);
            f32x4* xr = (f32x4*)(P.out + (size_t)m * D) + lane; const f32x4* gr = (const f32x4*)P.g_final + lane;
#pragma unroll
            for (int j = 0; j < 4; ++j) xr[64 * j] = xr[64 * j] * rs * gr[64 * j];
        }
    }
}

extern "C" void kernel_launch(void* const* d_in, const int* in_sizes, int n_in, void* d_out, int out_size, void* d_ws, size_t ws_size, hipStream_t stream) {
    static int grid = 0;
    if (grid == 0) {
        int dev = 0, cus = 0, per_cu = 0;
        (void)hipGetDevice(&dev);
        (void)hipDeviceGetAttribute(&cus, hipDeviceAttributeMultiprocessorCount, dev);
        (void)hipFuncSetAttribute((const void*)fwd_megakernel, hipFuncAttributeMaxDynamicSharedMemorySize, LDS_BYTES);
        (void)hipOccupancyMaxActiveBlocksPerMultiprocessor(&per_cu, (const void*)fwd_megakernel, 512, LDS_BYTES);
        if (per_cu < 1) fprintf(stderr, "kernel_launch: occupancy query says %d blocks per CU\n", per_cu);
        (void)hipGetLastError();
        grid = cus > 0 ? cus : 256;
    }
    Params p{};
    const float** pp = (const float**)&p;
    for (int i = 0; i < 18; ++i) pp[i] = (const float*)d_in[i];
    p.out = (float*)d_out; p.ws = (unsigned char*)d_ws;
#if MK_PER_PHASE
    for (int ph = 0; ph < MK_NPH; ++ph) for (int rep = 0; rep < (ph == MK_REP ? 2 : 1); ++rep) { p.ph_lo = ph; p.ph_hi = ph + 1; hipLaunchKernelGGL(fwd_megakernel, dim3(grid), dim3(512), LDS_BYTES, stream, p); }
#ifdef MK_DUMP
    p.ph_lo = MK_DUMP; p.ph_hi = MK_DUMP + 1; hipLaunchKernelGGL(fwd_megakernel, dim3(grid), dim3(512), LDS_BYTES, stream, p);
    if (MK_DUMP == 110) { p.ph_lo = 111; p.ph_hi = 112; hipLaunchKernelGGL(fwd_megakernel, dim3(grid), dim3(512), LDS_BYTES, stream, p); }
#endif
#else
    p.ph_lo = 0; p.ph_hi = MK_NPH;
    void* args[] = {&p};
    hipError_t e = hipLaunchCooperativeKernel((void*)fwd_megakernel, dim3(grid), dim3(512), args, LDS_BYTES, stream);
    if (e != hipSuccess) fprintf(stderr, "cooperative launch failed: %s (grid %d)\n", hipGetErrorString(e), grid);
#endif
}
```
